# Optimizing an MI355X kernel written in HIP

```python
import math
import jax, jax.numpy as jnp
from jax import lax
import numpy as np

D_MODEL = 2048
BATCH = 4
SEQ = 4096
DEPTH = 1

MIX_WIDTH = D_MODEL
DA_WIDTH = MIX_WIDTH // 2
DA_HEAD_DIM = 64
DA_HEADS = DA_WIDTH // (2 * DA_HEAD_DIM)
RW_WIDTH = MIX_WIDTH - DA_WIDTH
RW_HEAD_DIM = 64
RW_HEADS = RW_WIDTH // RW_HEAD_DIM
RW_DECAY_RANK = 64
RW_ICLR_RANK = 64
RW_GATE_RANK = 128
RW_COLS = 3 * RW_WIDTH + RW_DECAY_RANK + RW_ICLR_RANK + RW_GATE_RANK
IN_COLS = 3 * DA_WIDTH + RW_COLS
DA_SPLITS = [DA_WIDTH, 2 * DA_WIDTH, 3 * DA_WIDTH]
RW_SPLITS = [RW_WIDTH, 2 * RW_WIDTH, 3 * RW_WIDTH, 3 * RW_WIDTH + RW_DECAY_RANK, 3 * RW_WIDTH + RW_DECAY_RANK + RW_ICLR_RANK]
ROPE_THETA = 10000.0
Q_BLOCK = 128
N_GROUPS = 8
EXPERTS_PER_GROUP = 8
N_EXPERTS = N_GROUPS * EXPERTS_PER_GROUP
TOP_K = 2
D_EXPERT = D_MODEL // 4
EXPERT_BLOCK = 128
NORM_EPS = 1e-6
SUBLN_EPS = 1e-5
RW_GN_EPS = 64e-5

kernel_name = 'hybrid_diffattn_rwkv7_hmoe'


def rmsnorm(x, w, eps):
    xf = x.astype(jnp.float32)
    y = xf * lax.rsqrt(jnp.mean(xf * xf, axis=-1, keepdims=True) + eps)
    return (y * w.astype(jnp.float32)).astype(x.dtype)


def rope(x, pos):
    half = x.shape[-1] // 2
    inv = ROPE_THETA ** (-jnp.arange(half, dtype=jnp.float32) / half)
    ang = pos.astype(jnp.float32)[:, None] * inv[None, :]
    cos = jnp.cos(ang)[:, None, :]
    sin = jnp.sin(ang)[:, None, :]
    xf = x.astype(jnp.float32)
    x1, x2 = xf[..., :half], xf[..., half:]
    return jnp.concatenate([x1 * cos - x2 * sin, x2 * cos + x1 * sin], axis=-1).astype(x.dtype)


def diff_attention(q, k, v, lam, lam_init, subln_w):
    B, S = q.shape[0], q.shape[1]
    H, d = DA_HEADS, DA_HEAD_DIM
    nblk = S // Q_BLOCK
    scale = d ** -0.5
    qb = q.reshape(B, nblk, Q_BLOCK, 2 * H, d).transpose(1, 0, 2, 3, 4)
    kpos = jnp.arange(S)

    def block(args):
        qi, i = args
        s = jnp.einsum('bqhd,bkhd->bhqk', qi, k, preferred_element_type=jnp.float32) * scale
        qpos = i * Q_BLOCK + jnp.arange(Q_BLOCK)
        s = jnp.where(kpos[None, :] <= qpos[:, None], s, -jnp.inf)
        p = jax.nn.softmax(s, axis=-1).reshape(B, H, 2, Q_BLOCK, S)
        a = p[:, :, 0] - lam * p[:, :, 1]
        return jnp.einsum('bhqk,bkhe->bqhe', a.astype(v.dtype), v)

    o = lax.map(block, (qb, jnp.arange(nblk)))
    o = o.transpose(1, 0, 2, 3, 4).reshape(B, S, H, 2 * d)
    o = rmsnorm(o, subln_w, SUBLN_EPS).astype(jnp.float32) * (1.0 - lam_init)
    return o.reshape(B, S, DA_WIDTH).astype(v.dtype)


def wkv7_scan(r, w, k, v, a, b):
    B, S, H, N = r.shape

    def step(state, inp):
        r_t, w_t, k_t, v_t, a_t, b_t = inp
        sa = jnp.einsum('bhij,bhj->bhi', state, a_t)
        state = state * w_t[:, :, None, :] + sa[..., None] * b_t[:, :, None, :] + v_t[..., None] * k_t[:, :, None, :]
        y = jnp.einsum('bhij,bhj->bhi', state, r_t)
        return state, y

    xs = tuple(t.transpose(1, 0, 2, 3) for t in (r, w, k, v, a, b))
    s0 = jnp.zeros((B, H, N, N), jnp.float32)
    _, y = lax.scan(step, s0, xs)
    return y.transpose(1, 0, 2, 3)


def rwkv7_time_mix(z, mu, w0, w_up, a0, a_up, g_up, k_k, k_a, r_k, lnx_w, lnx_b):
    B, S, _ = z.shape
    H, N = RW_HEADS, RW_HEAD_DIM
    z_prev = jnp.pad(z, ((0, 0), (1, 0), (0, 0)))[:, :S]
    z = z + (z_prev - z) * mu
    r, k, v, wd, ad, gd = jnp.split(z, RW_SPLITS, axis=-1)
    w = -jax.nn.softplus(-(w0 + jnp.tanh(wd) @ w_up)) - 0.5
    decay = jnp.exp(-jnp.exp(w.astype(jnp.float32)))
    a = jax.nn.sigmoid(a0 + ad @ a_up)
    g = jax.nn.sigmoid(gd) @ g_up
    heads = lambda t: t.reshape(B, S, H, N).astype(jnp.float32)
    kk = heads(k * k_k)
    kk = kk / jnp.maximum(jnp.sqrt(jnp.sum(kk * kk, axis=-1, keepdims=True)), 1e-12)
    k = k * (1 + (a - 1) * k_a)
    r, k, v, a = heads(r), heads(k), heads(v), heads(a)
    y = wkv7_scan(r, heads(decay), k, v, -kk, kk * a)
    mean = jnp.mean(y, axis=-1, keepdims=True)
    var = jnp.mean(jnp.square(y - mean), axis=-1, keepdims=True)
    y = (y - mean) * lax.rsqrt(var + RW_GN_EPS)
    y = y * lnx_w.astype(jnp.float32).reshape(H, N) + lnx_b.astype(jnp.float32).reshape(H, N)
    y = y + jnp.sum(r * k * r_k.astype(jnp.float32), axis=-1, keepdims=True) * v
    return (y.reshape(B, S, RW_WIDTH) * g.astype(jnp.float32)).astype(z.dtype)


def grouped_expert_ffn(xt, eid, gate, w1, w3, w2):
    T, D = xt.shape
    M = T * TOP_K
    e_flat = eid.reshape(M)
    order = jnp.argsort(e_flat)
    e_sorted = e_flat[order]
    counts = jnp.zeros((N_EXPERTS,), jnp.int32).at[e_flat].add(1)
    start = jnp.cumsum(counts) - counts
    padded = (counts + EXPERT_BLOCK - 1) // EXPERT_BLOCK * EXPERT_BLOCK
    pend = jnp.cumsum(padded)
    pstart = pend - padded
    dest = pstart[e_sorted] + (jnp.arange(M) - start[e_sorted])
    n_blocks = -(-M // EXPERT_BLOCK) + N_EXPERTS
    P = n_blocks * EXPERT_BLOCK
    tok = jnp.full((P,), T, jnp.int32).at[dest].set((order // TOP_K).astype(jnp.int32))
    gbuf = jnp.zeros((P,), jnp.float32).at[dest].set(gate.reshape(M)[order])
    blk_start = jnp.arange(n_blocks) * EXPERT_BLOCK
    blk_e = jnp.minimum(jnp.sum(blk_start[:, None] >= pend[None, :], axis=1), N_EXPERTS - 1)
    x_pad = jnp.concatenate([xt, jnp.zeros((1, D), xt.dtype)], axis=0)
    xb = x_pad[tok].reshape(n_blocks, EXPERT_BLOCK, D)

    def block(args):
        xi, e = args
        h = jax.nn.silu(xi @ w1[e]) * (xi @ w3[e])
        return h @ w2[e]

    yb = lax.map(block, (xb, blk_e)).reshape(P, D)
    yb = yb * gbuf[:, None].astype(yb.dtype)
    return jnp.zeros((T + 1, D), yb.dtype).at[tok].add(yb)[:T]


def hier_moe(xn, wg, bg, we, be, w1, w3, w2):
    B, S, D = xn.shape
    T = B * S
    xt = xn.reshape(T, D)
    pg = jax.nn.softmax(jnp.dot(xt, wg, preferred_element_type=jnp.float32) + bg.astype(jnp.float32), axis=-1)
    g_sel = jnp.argmax(pg, axis=-1)
    p_g = jnp.take_along_axis(pg, g_sel[:, None], axis=1)
    le = (jnp.dot(xt, we, preferred_element_type=jnp.float32) + be.astype(jnp.float32)).reshape(T, N_GROUPS, EXPERTS_PER_GROUP)
    le = jnp.take_along_axis(le, g_sel[:, None, None], axis=1)[:, 0]
    pe = jax.nn.softmax(le, axis=-1)
    top_p, top_i = lax.top_k(pe, TOP_K)
    gate = p_g * top_p / jnp.sum(top_p, axis=-1, keepdims=True)
    eid = g_sel[:, None].astype(jnp.int32) * EXPERTS_PER_GROUP + top_i.astype(jnp.int32)
    return grouped_expert_ffn(xt, eid, gate, w1, w3, w2).reshape(B, S, D)


def setup_inputs(seed: int = 0) -> dict:
    key = jax.random.key(seed)
    ks = jax.random.split(key, 30)
    f32 = jnp.float32
    L = DEPTH

    def nrm(k, shape, scale):
        return jax.random.normal(k, shape, f32) * scale

    return {
        'x': nrm(ks[0], (BATCH, SEQ, D_MODEL), 1.0),
        'norm1_w': 1.0 + nrm(ks[1], (L, D_MODEL), 0.02),
        'w_in': nrm(ks[2], (L, D_MODEL, IN_COLS), D_MODEL ** -0.5),
        'lam_q1': nrm(ks[3], (L, DA_HEAD_DIM), 0.1),
        'lam_k1': nrm(ks[4], (L, DA_HEAD_DIM), 0.1),
        'lam_q2': nrm(ks[5], (L, DA_HEAD_DIM), 0.1),
        'lam_k2': nrm(ks[6], (L, DA_HEAD_DIM), 0.1),
        'subln_w': 1.0 + nrm(ks[7], (L, 2 * DA_HEAD_DIM), 0.02),
        'rw_mu': jax.random.uniform(ks[8], (L, RW_COLS), f32),
        'rw_w0': jax.random.uniform(ks[9], (L, RW_WIDTH), f32, -6.0, -1.0),
        'rw_w_up': nrm(ks[10], (L, RW_DECAY_RANK, RW_WIDTH), 0.1),
        'rw_a0': nrm(ks[11], (L, RW_WIDTH), 0.1),
        'rw_a_up': nrm(ks[12], (L, RW_ICLR_RANK, RW_WIDTH), 0.5 * RW_ICLR_RANK ** -0.5),
        'rw_g_up': nrm(ks[13], (L, RW_GATE_RANK, RW_WIDTH), RW_GATE_RANK ** -0.5),
        'rw_k_k': 0.85 + nrm(ks[14], (L, RW_WIDTH), 0.05),
        'rw_k_a': 1.0 + nrm(ks[15], (L, RW_WIDTH), 0.05),
        'rw_r_k': nrm(ks[16], (L, RW_HEADS, RW_HEAD_DIM), 0.1),
        'rw_lnx_w': 1.0 + nrm(ks[17], (L, RW_WIDTH), 0.02),
        'rw_lnx_b': nrm(ks[18], (L, RW_WIDTH), 0.02),
        'w_out': nrm(ks[19], (L, MIX_WIDTH, D_MODEL), MIX_WIDTH ** -0.5),
        'norm2_w': 1.0 + nrm(ks[20], (L, D_MODEL), 0.02),
        'router_group_w': nrm(ks[21], (L, D_MODEL, N_GROUPS), D_MODEL ** -0.5),
        'router_group_b': nrm(ks[22], (L, N_GROUPS), 0.01),
        'router_expert_w': nrm(ks[23], (L, D_MODEL, N_EXPERTS), D_MODEL ** -0.5),
        'router_expert_b': nrm(ks[24], (L, N_EXPERTS), 0.01),
        'moe_w1': nrm(ks[25], (L, N_EXPERTS, D_MODEL, D_EXPERT), D_MODEL ** -0.5),
        'moe_w3': nrm(ks[26], (L, N_EXPERTS, D_MODEL, D_EXPERT), D_MODEL ** -0.5),
        'moe_w2': nrm(ks[27], (L, N_EXPERTS, D_EXPERT, D_MODEL), D_EXPERT ** -0.5),
        'final_norm_w': 1.0 + nrm(ks[28], (D_MODEL,), 0.02),
    }


def reference(x, norm1_w, w_in, lam_q1, lam_k1, lam_q2, lam_k2, subln_w, rw_mu, rw_w0, rw_w_up, rw_a0, rw_a_up, rw_g_up, rw_k_k, rw_k_a, rw_r_k, rw_lnx_w, rw_lnx_b, w_out, norm2_w, router_group_w, router_group_b, router_expert_w, router_expert_b, moe_w1, moe_w3, moe_w2, final_norm_w):
    B, S, _ = x.shape
    pos = jnp.arange(S)
    h = x
    for l in range(DEPTH):
        xn = rmsnorm(h, norm1_w[l], NORM_EPS)
        z = xn @ w_in[l]
        dq, dk, dv, zr = jnp.split(z, DA_SPLITS, axis=-1)
        q = rope(dq.reshape(B, S, 2 * DA_HEADS, DA_HEAD_DIM), pos)
        k = rope(dk.reshape(B, S, 2 * DA_HEADS, DA_HEAD_DIM), pos)
        v = dv.reshape(B, S, DA_HEADS, 2 * DA_HEAD_DIM)
        lam_init = 0.8 - 0.6 * math.exp(-0.3 * l)
        lam = (jnp.exp(jnp.sum(lam_q1[l].astype(jnp.float32) * lam_k1[l].astype(jnp.float32)))
               - jnp.exp(jnp.sum(lam_q2[l].astype(jnp.float32) * lam_k2[l].astype(jnp.float32))) + lam_init)
        o_da = diff_attention(q, k, v, lam, lam_init, subln_w[l])
        o_rw = rwkv7_time_mix(zr, rw_mu[l], rw_w0[l], rw_w_up[l], rw_a0[l], rw_a_up[l], rw_g_up[l],
                              rw_k_k[l], rw_k_a[l], rw_r_k[l], rw_lnx_w[l], rw_lnx_b[l])
        h = h + jnp.concatenate([o_da, o_rw], axis=-1) @ w_out[l]
        xn2 = rmsnorm(h, norm2_w[l], NORM_EPS)
        h = h + hier_moe(xn2, router_group_w[l], router_group_b[l], router_expert_w[l], router_expert_b[l],
                         moe_w1[l], moe_w3[l], moe_w2[l])
    return rmsnorm(h, final_norm_w, NORM_EPS)
```

```cpp
#include <hip/hip_runtime.h>
#include <hip/hip_cooperative_groups.h>
#include <cstdio>
#include <cstdint>
#include <cmath>
namespace cg = cooperative_groups;

#ifndef MK_N_LAUNCHES
#define MK_N_LAUNCHES 1
#endif

namespace pg8 {
#define PG8_LAS __attribute__((address_space(3)))
typedef unsigned short bf16_t;
typedef short bf16x8 __attribute__((ext_vector_type(8)));
typedef float f32x4 __attribute__((ext_vector_type(4)));
typedef unsigned u32x4 __attribute__((ext_vector_type(4)));
constexpr int BM = 256, BK = 64, HALF = 128, HTB = HALF * BK * 2  , STAGE_BYTES = 8 * HTB, NXCD = 8, WGM = 8;

__host__ __device__ __forceinline__ int lds_byte(int r, int c) { const int st = (r >> 4) * 2 + (c >> 5), rr = r & 15, cc = c & 31, ob = rr * 64 + cc * 2; return st * 1024 + (ob ^ (((ob >> 9) & 1) << 5)); }
__host__ __device__ __forceinline__ void stage_rc(int b, int& R, int& C) { const int st = b / 1024, sb = b % 1024, swz = sb ^ (((sb >> 9) & 1) << 5); R = (st >> 1) * 16 + swz / 64; C = (st & 1) * 32 + (swz % 64) / 2; }
__host__ __device__ __forceinline__ int perm32(int rho) { const int n = rho >> 4, i = rho & 15; return 8 * (i >> 2) + 4 * n + (i & 3); }

struct Unit { int pm, pn; };
struct Gemm { const bf16_t* A; const bf16_t* Bt; int M, N, K; };

struct StaticOrder {
    int nM, nN, nwg, G, c;
    __host__ __device__ void init(int M, int N, int G_, int c_) { nM = M / BM; nN = N / BM; nwg = nM * nN; G = G_; c = c_; }
    __host__ __device__ bool next(int i, Unit& u) const {
        const long L = (long)i * G + c; if (L >= nwg) return false;
        int wgid = (int)L; { const int q = nwg / NXCD, r = nwg % NXCD, xcd = wgid % NXCD, off = wgid / NXCD; wgid = (xcd < r ? xcd * (q + 1) : r * (q + 1) + (xcd - r) * q) + off; }
        const int nig = WGM * nN, gid = wgid / nig, fm = gid * WGM, gsz = (nM - fm) < WGM ? (nM - fm) : WGM;
        u.pm = fm + ((wgid % nig) % gsz); u.pn = (wgid % nig) / gsz; return true;
    }
    __device__ __forceinline__ void a_ready(const Unit&) const {}
    __device__ __forceinline__ void done(const Unit&) const {}
};

__device__ __forceinline__ unsigned cvt_pk_bf16(float lo, float hi) { unsigned r; asm volatile("v_cvt_pk_bf16_f32 %0, %1, %2" : "=v"(r) : "v"(lo), "v"(hi)); return r; }
typedef float f32x2 __attribute__((ext_vector_type(2)));
__device__ __forceinline__ f32x2 gelu_pk(f32x2 v) {
    const f32x2 av = __builtin_elementwise_abs(v), d = av * 0.2316418882f + 1.0f;
    f32x2 t; t.x = __builtin_amdgcn_rcpf(d.x); t.y = __builtin_amdgcn_rcpf(d.y);
    f32x2 q = t * 0.5307027145f + (-0.7265760135f); q = q * t + 0.7107068705f; q = q * t + (-0.142248368f); q = q * t + 0.127414796f; q = q * t;
    const f32x2 s = (v * v) * (-0.72134752044f);
    f32x2 e; e.x = __builtin_amdgcn_exp2f(s.x); e.y = __builtin_amdgcn_exp2f(s.y);
    const f32x2 m = v * (q * e), r = v - m;
    f32x2 o; o.x = v.x < 0.f ? m.x : r.x; o.y = v.y < 0.f ? m.y : r.y; return o;
}

template <int ACT  > struct EpiBf16 {
    static constexpr bool PERM = true, AFTER_DRAIN = false; static_assert(ACT == 0 || ACT == 1, "EpiBf16: ACT is 0 (none) or 1 (gelu_pk)");
    bf16_t* O; int ldc; const float* bias; int split_cols; size_t split_stride; float scale0;
    __device__ __forceinline__ void operator()(const f32x4 (&acc)[2][2][4][2], const Unit& u, int wr, int wc, int fr, int fq) const {
        const int row0 = u.pm * BM + wr * 64 + fr; int colt = u.pn * BM; bf16_t* base = O;
        float sc = 1.f; if (split_cols) { const int t = colt / split_cols; base += (size_t)t * split_stride; colt -= t * split_cols; if (t == 0) sc = scale0; }
        const int col0 = colt + wc * 32 + 8 * fq, bcol0 = u.pn * BM + wc * 32 + 8 * fq;
        f32x4 bv[2][2];
#pragma unroll
        for (int bj = 0; bj < 2; ++bj)
#pragma unroll
            for (int n = 0; n < 2; ++n) bv[bj][n] = bias ? *(const f32x4*)(bias + bcol0 + bj * HALF + 4 * n) : (f32x4){0.f, 0.f, 0.f, 0.f};
#pragma unroll
        for (int ai = 0; ai < 2; ++ai)
#pragma unroll
            for (int m = 0; m < 4; ++m) { bf16_t* rowp = base + (size_t)(row0 + ai * HALF + m * 16) * ldc + col0;
#pragma unroll
                for (int bj = 0; bj < 2; ++bj) { f32x4 v0 = acc[ai][bj][m][0] + bv[bj][0], v1 = acc[ai][bj][m][1] + bv[bj][1];
                    if (ACT == 1) { f32x2 a = gelu_pk((f32x2){v0[0], v0[1]}), b = gelu_pk((f32x2){v0[2], v0[3]}), c = gelu_pk((f32x2){v1[0], v1[1]}), d = gelu_pk((f32x2){v1[2], v1[3]});
                        v0 = (f32x4){a.x, a.y, b.x, b.y}; v1 = (f32x4){c.x, c.y, d.x, d.y}; }
                    v0 = v0 * sc; v1 = v1 * sc; u32x4 w; w.x = cvt_pk_bf16(v0[0], v0[1]); w.y = cvt_pk_bf16(v0[2], v0[3]); w.z = cvt_pk_bf16(v1[0], v1[1]); w.w = cvt_pk_bf16(v1[2], v1[3]);
                    *(u32x4*)(rowp + bj * HALF) = w; } }
    }
};

struct EpiF32Res {
    static constexpr bool PERM = false, AFTER_DRAIN = false;
    const float* base; float* out; int ldc;
    __device__ __forceinline__ void operator()(const f32x4 (&acc)[2][2][4][2], const Unit& u, int wr, int wc, int fr, int fq) const {
        const int row0 = u.pm * BM + wr * 64 + fr, col0 = u.pn * BM + wc * 32 + 4 * fq;
#pragma unroll
        for (int ai = 0; ai < 2; ++ai)
#pragma unroll
            for (int m = 0; m < 4; ++m) { const size_t off = (size_t)(row0 + ai * HALF + m * 16) * ldc + col0;
#pragma unroll
                for (int bj = 0; bj < 2; ++bj)
#pragma unroll
                    for (int n = 0; n < 2; ++n) { const f32x4 bs = *(const f32x4*)(base + off + bj * HALF + n * 16); *(f32x4*)(out + off + bj * HALF + n * 16) = bs + acc[ai][bj][m][n]; } }
    }
};
struct EpiSwiGLU {
    static constexpr bool PERM = true, AFTER_DRAIN = false;
    bf16_t* O;
    __device__ __forceinline__ void operator()(const f32x4 (&acc)[2][2][4][2], const Unit& u, int wr, int wc, int fr, int fq) const {
        const int row0 = u.pm * BM + wr * 64 + fr; const int col0 = (u.pn & 3) * HALF + wc * 32 + 8 * fq;
#pragma unroll
        for (int ai = 0; ai < 2; ++ai)
#pragma unroll
            for (int m = 0; m < 4; ++m) { bf16_t* rowp = O + (size_t)(row0 + ai * HALF + m * 16) * 512 + col0;
                float o[8];
#pragma unroll
                for (int n = 0; n < 2; ++n)
#pragma unroll
                    for (int i = 0; i < 4; ++i) { const float a = acc[ai][0][m][n][i], b = acc[ai][1][m][n][i]; o[n * 4 + i] = a * __builtin_amdgcn_rcpf(1.0f + __expf(-a)) * b; }
                u32x4 w; w.x = cvt_pk_bf16(o[0], o[1]); w.y = cvt_pk_bf16(o[2], o[3]); w.z = cvt_pk_bf16(o[4], o[5]); w.w = cvt_pk_bf16(o[6], o[7]);
                *(u32x4*)rowp = w; }
    }
};
struct MoeOrder {
    const int* tileE; int nunits, ncol, G, c;
    __device__ __forceinline__ bool next(int i, Unit& u) const {
        const int L = i * G + c; if (L >= nunits) return false;
        const int pm = L / ncol; const int e = __builtin_amdgcn_readfirstlane(tileE[pm]);
        u.pm = pm; u.pn = e * ncol + (L - pm * ncol); return true;
    }
    __device__ __forceinline__ void a_ready(const Unit&) const {}
    __device__ __forceinline__ void done(const Unit&) const {}
};

template <class Epi, class Sched, bool ALIGN_EPI = false, bool SP2 = false>
__device__ __forceinline__ void gemm_phase(PG8_LAS unsigned char* lds, const Gemm g, const Sched& S, const Epi& E) {
    const int tid = threadIdx.x, wid = __builtin_amdgcn_readfirstlane(tid >> 6), lane = tid & 63, wr = wid >> 2, wc = wid & 3, fr = lane & 15, fq = lane >> 4;
    const int K = g.K, nt = K / BK;
    unsigned voffA[2], voffB[2];
#pragma unroll
    for (int i = 0; i < 2; ++i) { int R, C; stage_rc(tid * 16 + i * 8192, R, C); const int Rb = Epi::PERM ? ((R & ~31) + perm32(R & 31)) : R;
        voffA[i] = (unsigned)(R * K + C) * 2u; voffB[i] = (unsigned)(Rb * K + C) * 2u; }
    const size_t kstep = (size_t)(BK * 2);
    const size_t hstep = (size_t)HALF * K * 2;
    const size_t tstep = 2 * hstep;
    const unsigned ldsw = (unsigned)wid * 1024u;
    const int aoff = lds_byte(wr * 64 + fr, fq * 8), boff = lds_byte(wc * 32 + fr, fq * 8);
#define PG8_SA(b, h) (((b) * 2 + (h)) * HTB)
#define PG8_SB(b, h) ((4 + (b) * 2 + (h)) * HTB)
#define PG8_STAGE(bufoff, gbase, voff) do { _Pragma("unroll") for (int _i = 0; _i < 2; ++_i) \
        __builtin_amdgcn_global_load_lds((const unsigned*)((const char*)(gbase) + (voff)[_i]), (PG8_LAS unsigned*)(lds + (bufoff) + ldsw + _i * 8192), 16, 0, 0); } while (0)
#define PG8_LDA(dst, b, h) do { _Pragma("unroll") for (int m = 0; m < 4; ++m) _Pragma("unroll") for (int k = 0; k < 2; ++k) dst[m][k] = *(const PG8_LAS bf16x8*)(lds + PG8_SA(b, h) + aoff + m * 2048 + k * 1024); } while (0)
#define PG8_LDB(dst, b, h) do { _Pragma("unroll") for (int n = 0; n < 2; ++n) _Pragma("unroll") for (int k = 0; k < 2; ++k) dst[n][k] = *(const PG8_LAS bf16x8*)(lds + PG8_SB(b, h) + boff + n * 2048 + k * 1024); } while (0)
#define PG8_MMA(ai, bj, At, Bt) do { __builtin_amdgcn_s_setprio(1); _Pragma("unroll") for (int m = 0; m < 4; ++m) _Pragma("unroll") for (int n = 0; n < 2; ++n) _Pragma("unroll") for (int k = 0; k < 2; ++k) \
        acc[ai][bj][m][n] = __builtin_amdgcn_mfma_f32_16x16x32_bf16(Bt[n][k], At[m][k], acc[ai][bj][m][n], 0, 0, 0); __builtin_amdgcn_s_setprio(0); } while (0)
#define PG8_WAIT_V(n) asm volatile("s_waitcnt vmcnt(" #n ")" ::: "memory")
#define PG8_WAIT_L(n) asm volatile("s_waitcnt lgkmcnt(" #n ")" ::: "memory")
#define PG8_BAR __builtin_amdgcn_s_barrier()
#define PG8_SCHED __builtin_amdgcn_sched_barrier(0)
    Unit cur, nxt; int ui = 0;
    if (!S.next(0, cur)) return;
    f32x4 acc[2][2][4][2];
#pragma unroll
    for (int a = 0; a < 2; ++a)
#pragma unroll
        for (int b = 0; b < 2; ++b)
#pragma unroll
            for (int m = 0; m < 4; ++m)
#pragma unroll
                for (int n = 0; n < 2; ++n) acc[a][b][m][n] = (f32x4){0.f, 0.f, 0.f, 0.f};
    bf16x8 At[4][2], B0[2][2], B1[2][2];
    const char* cA = (const char*)g.A + (size_t)cur.pm * tstep; const char* cB = (const char*)g.Bt + (size_t)cur.pn * tstep;
    S.a_ready(cur);
    if constexpr (SP2) {
        PG8_STAGE(PG8_SB(0, 0), cB, voffB); PG8_STAGE(PG8_SB(0, 1), cB + hstep, voffB); PG8_STAGE(PG8_SA(0, 0), cA, voffA); PG8_STAGE(PG8_SA(0, 1), cA + hstep, voffA);
        if (wr == 1) PG8_BAR;
        PG8_WAIT_V(2); PG8_BAR;
        PG8_STAGE(PG8_SB(1, 0), cB + kstep, voffB); PG8_STAGE(PG8_SA(1, 0), cA + kstep, voffA); PG8_STAGE(PG8_SB(1, 1), cB + hstep + kstep, voffB);
        PG8_WAIT_V(6); PG8_BAR;
    } else {
        PG8_STAGE(PG8_SB(0, 0), cB, voffB); PG8_STAGE(PG8_SA(0, 0), cA, voffA); PG8_STAGE(PG8_SB(0, 1), cB + hstep, voffB); PG8_STAGE(PG8_SA(0, 1), cA + hstep, voffA);
        if (wr == 1) PG8_BAR;
        PG8_WAIT_V(4); PG8_BAR;
        PG8_STAGE(PG8_SB(1, 0), cB + kstep, voffB); PG8_STAGE(PG8_SA(1, 0), cA + kstep, voffA); PG8_STAGE(PG8_SB(1, 1), cB + hstep + kstep, voffB);
        PG8_WAIT_V(6); PG8_BAR;
    }
    for (;;) {
        const bool has_next = S.next(ui + 1, nxt);
        const char* nA = has_next ? (const char*)g.A + (size_t)nxt.pm * tstep : cA; const char* nB = has_next ? (const char*)g.Bt + (size_t)nxt.pn * tstep : cB;
        for (int t = 0; t < nt; t += 2) {
            const bool last = (t == nt - 2);
            const char* a1 = cA + (size_t)(t + 1) * kstep;
            const char* a2 = last ? nA : cA + (size_t)(t + 2) * kstep; const char* b2 = last ? nB : cB + (size_t)(t + 2) * kstep;
            const char* a3 = a2 + kstep; const char* b3 = b2 + kstep;
            if (last && has_next) S.a_ready(nxt);
            if constexpr (SP2) {
            PG8_LDB(B0, 0, 0); PG8_LDB(B1, 0, 1); PG8_SCHED; PG8_LDA(At, 0, 0); PG8_STAGE(PG8_SA(1, 1), a1 + hstep, voffA);
            PG8_WAIT_V(8); PG8_WAIT_L(0); PG8_BAR; PG8_MMA(0, 0, At, B0); PG8_MMA(0, 1, At, B1); PG8_BAR; PG8_SCHED;
            PG8_LDA(At, 0, 1); PG8_STAGE(PG8_SB(0, 0), b2, voffB); PG8_STAGE(PG8_SB(0, 1), b2 + hstep, voffB); PG8_STAGE(PG8_SA(0, 0), a2, voffA);
            PG8_WAIT_V(8); PG8_WAIT_L(0); PG8_BAR; PG8_MMA(1, 0, At, B0); PG8_MMA(1, 1, At, B1); PG8_BAR; PG8_SCHED;
            PG8_LDB(B0, 1, 0); PG8_LDB(B1, 1, 1); PG8_SCHED; PG8_LDA(At, 1, 0); PG8_STAGE(PG8_SA(0, 1), a2 + hstep, voffA);
            PG8_WAIT_V(8); PG8_WAIT_L(0); PG8_BAR; PG8_MMA(0, 0, At, B0); PG8_MMA(0, 1, At, B1); PG8_BAR; PG8_SCHED;
            PG8_LDA(At, 1, 1); PG8_STAGE(PG8_SB(1, 0), b3, voffB); PG8_STAGE(PG8_SB(1, 1), b3 + hstep, voffB); PG8_STAGE(PG8_SA(1, 0), a3, voffA);
            PG8_WAIT_V(8); PG8_WAIT_L(0); PG8_BAR; PG8_MMA(1, 0, At, B0); PG8_MMA(1, 1, At, B1); PG8_BAR; PG8_SCHED;
            } else {
            PG8_LDB(B0, 0, 0); PG8_SCHED; PG8_LDA(At, 0, 0); PG8_STAGE(PG8_SA(1, 1), a1 + hstep, voffA);
            PG8_WAIT_L(8); PG8_BAR; PG8_WAIT_L(0); PG8_MMA(0, 0, At, B0); PG8_BAR; PG8_SCHED;
            PG8_LDB(B1, 0, 1); PG8_STAGE(PG8_SB(0, 0), b2, voffB);
            PG8_BAR; PG8_WAIT_L(0); PG8_MMA(0, 1, At, B1); PG8_BAR;
            PG8_LDA(At, 0, 1); PG8_STAGE(PG8_SA(0, 0), a2, voffA);
            PG8_BAR; PG8_WAIT_L(0); PG8_MMA(1, 0, At, B0); PG8_BAR; PG8_SCHED;
            PG8_STAGE(PG8_SB(0, 1), b2 + hstep, voffB);
            PG8_WAIT_V(6); PG8_BAR; PG8_MMA(1, 1, At, B1); PG8_BAR;
            PG8_LDB(B0, 1, 0); PG8_SCHED; PG8_LDA(At, 1, 0); PG8_STAGE(PG8_SA(0, 1), a2 + hstep, voffA);
            PG8_WAIT_L(8); PG8_BAR; PG8_WAIT_L(0); PG8_MMA(0, 0, At, B0); PG8_BAR; PG8_SCHED;
            PG8_LDB(B1, 1, 1); PG8_STAGE(PG8_SB(1, 0), b3, voffB);
            PG8_BAR; PG8_WAIT_L(0); PG8_MMA(0, 1, At, B1); PG8_BAR;
            PG8_LDA(At, 1, 1); PG8_STAGE(PG8_SA(1, 0), a3, voffA);
            PG8_BAR; PG8_WAIT_L(0); PG8_MMA(1, 0, At, B0); PG8_BAR; PG8_SCHED;
            PG8_STAGE(PG8_SB(1, 1), b3 + hstep, voffB);
            PG8_WAIT_V(6); PG8_BAR; PG8_MMA(1, 1, At, B1); PG8_BAR;
            }
        }
        if constexpr (ALIGN_EPI) { if (wr == 0) PG8_BAR; }
        if constexpr (!Epi::AFTER_DRAIN) { E(acc, cur, wr, wc, fr, fq); S.done(cur); }
        if (!has_next) break;
#pragma unroll
        for (int a = 0; a < 2; ++a)
#pragma unroll
            for (int b = 0; b < 2; ++b)
#pragma unroll
                for (int m = 0; m < 4; ++m)
#pragma unroll
                    for (int n = 0; n < 2; ++n) acc[a][b][m][n] = (f32x4){0.f, 0.f, 0.f, 0.f};
        cur = nxt; cA = nA; cB = nB; ++ui;
        if constexpr (ALIGN_EPI) { if (wr == 1) PG8_BAR; }
    }
    PG8_WAIT_V(0);
    if constexpr (!ALIGN_EPI) { if (wr == 0) PG8_BAR; }
    PG8_BAR;
    if constexpr (Epi::AFTER_DRAIN) { E.fused(acc, cur, wr, wc, fr, fq, lds, wid, lane); S.done(cur); }
#undef PG8_SA
#undef PG8_SB
#undef PG8_STAGE
#undef PG8_LDA
#undef PG8_LDB
#undef PG8_MMA
#undef PG8_WAIT_V
#undef PG8_WAIT_L
#undef PG8_BAR
#undef PG8_SCHED
}
}

constexpr int NWAVES = 8, NTHR = 512;
constexpr int BATCH = 4, SEQ = 4096, DM = 2048, T = BATCH * SEQ;
constexpr int INC = 6400;
constexpr int ZK = 1024, ZV = 2048, ZR = 3072;
constexpr int NE = 64, DE = 512;
constexpr int PMAX = 49152;
constexpr int NPHASE = 10;
constexpr int N_LAUNCHES = MK_N_LAUNCHES;
constexpr float C2 = 0.125f * 1.4426950408889634f;
constexpr float LAM_INIT = 0.2f;

constexpr size_t MiB = 1u << 20;
constexpr size_t WS_CTL = 0, CTL_ZERO_BYTES = 64 * 1024;
constexpr size_t WS_SMALL = 1 * MiB;
constexpr size_t WS_WIN = 9 * MiB;
constexpr size_t WS_WOUT = 34 * MiB;
constexpr size_t WS_W13 = 42 * MiB;
constexpr size_t WS_W2 = 298 * MiB;
constexpr size_t WS_XN = 426 * MiB;
constexpr size_t WS_Z = 490 * MiB;
constexpr size_t WS_STREAM = 690 * MiB;
constexpr size_t WS_HID = 914 * MiB;
constexpr size_t WS_END = 962 * MiB;
constexpr size_t SM_WUP = 0;
constexpr size_t SM_AUP = 128 * 1024;
constexpr size_t SM_GUP = 256 * 1024;
constexpr size_t SM_WRT = 512 * 1024;
constexpr size_t SM_BONUS = 2 * MiB;
constexpr size_t SM_ROUTE_E = 3 * MiB;
constexpr size_t SM_ROUTE_R = 3 * MiB + 128 * 1024;
constexpr size_t SM_ROUTE_G = 3 * MiB + 256 * 1024;
constexpr size_t SM_R2 = 3 * MiB + 384 * 1024;
constexpr size_t SM_SLOT = 3 * MiB + 512 * 1024;
constexpr size_t SM_TILEE = 4 * MiB;
constexpr int CW_QHEAD = 64;
constexpr int CW_NT = 128;
constexpr int CW_CNT = 256;

constexpr int RING_BYTES = 131072;
constexpr int MISC_OFF = RING_BYTES;
constexpr int LDS_BYTES = 147456;

#define GAS __attribute__((address_space(1)))
#define LAS __attribute__((address_space(3)))
typedef unsigned short bf16;
typedef unsigned v4u __attribute__((ext_vector_type(4)));
typedef unsigned v2u __attribute__((ext_vector_type(2)));
typedef float f32x4 __attribute__((ext_vector_type(4)));
typedef float f32x16 __attribute__((ext_vector_type(16)));
typedef short bf16x8 __attribute__((ext_vector_type(8)));
typedef short s16x4 __attribute__((ext_vector_type(4)));

__device__ __forceinline__ unsigned f2bf(float f) { unsigned u = __builtin_bit_cast(unsigned, f); return (u + 0x7fffu + ((u >> 16) & 1u)) >> 16; }
__device__ __forceinline__ unsigned pk2(float lo, float hi) { return f2bf(lo) | (f2bf(hi) << 16); }
__device__ __forceinline__ float bf2f(unsigned b) { return __builtin_bit_cast(float, b << 16); }
__device__ __forceinline__ float bflo(unsigned w) { return __builtin_bit_cast(float, w << 16); }
__device__ __forceinline__ float bfhi(unsigned w) { return __builtin_bit_cast(float, w & 0xffff0000u); }
__device__ __forceinline__ float wave_sum(float v) {
#pragma unroll
    for (int o = 1; o < 64; o <<= 1) v += __shfl_xor(v, o);
    return v;
}
template <int CTRL> __device__ __forceinline__ float dpp_mov(float x) { return __builtin_bit_cast(float, __builtin_amdgcn_update_dpp(0, __builtin_bit_cast(int, x), CTRL, 0xF, 0xF, true)); }
__device__ __forceinline__ float reduce16(float x) {
    x += dpp_mov<0xB1>(x);
    x += dpp_mov<0x4E>(x);
    x += dpp_mov<0x141>(x);
    x += dpp_mov<0x140>(x);
    return x;
}
__device__ __forceinline__ float sigmoidf_(float x) { return __builtin_amdgcn_rcpf(1.0f + __expf(-x)); }

struct Frame {
    LAS unsigned char* lds;
    volatile LAS unsigned* MISC;
    unsigned* ctl;
    int tid, lane, wave, vcu, G;
    const float *x, *norm1_w, *w_in, *lam_q1, *lam_k1, *lam_q2, *lam_k2, *subln_w, *rw_mu, *rw_w0, *rw_w_up, *rw_a0, *rw_a_up, *rw_g_up, *rw_k_k, *rw_k_a, *rw_r_k, *rw_lnx_w, *rw_lnx_b,
                *w_out, *norm2_w, *rg_w, *rg_b, *re_w, *re_b, *moe_w1, *moe_w3, *moe_w2, *final_w;
    float* out;
    bf16 *WIN, *WOUT, *W13, *W2, *XN, *MIX, *Z, *XG, *STREAM, *Y, *HID, *WUP, *AUP, *GUP;
    float *WRT, *BONUS, *ROUTE_G, *R2;
    int *ROUTE_E, *ROUTE_R, *SLOT, *TILEE;
};

__device__ __forceinline__ void p0_transpose_item(const float* W, int N, bf16* WT, int ldt, int dst_row0, int k0, int n0, const float* kscale, LAS float* scr, int lane) {
#pragma unroll 8
    for (int i = 0; i < 32; ++i) { const int kk = 2 * i + (lane >> 5); float v = W[(size_t)(k0 + kk) * N + n0 + (lane & 31)]; if (kscale) v *= kscale[k0 + kk]; scr[kk * 33 + (lane & 31)] = v; }
    asm volatile("s_waitcnt lgkmcnt(0)" ::: "memory");
    const int c = lane & 7;
#pragma unroll
    for (int j = 0; j < 4; ++j) { const int n = (lane >> 3) + 8 * j; const LAS float* s = scr + (8 * c) * 33 + n;
        v4u o; o.x = pk2(s[0 * 33], s[1 * 33]); o.y = pk2(s[2 * 33], s[3 * 33]); o.z = pk2(s[4 * 33], s[5 * 33]); o.w = pk2(s[6 * 33], s[7 * 33]);
        *(v4u*)(WT + (size_t)(dst_row0 + n) * ldt + k0 + 8 * c) = o; }
    asm volatile("s_waitcnt lgkmcnt(0)" ::: "memory");
}
__device__ __forceinline__ void p0_prologue(const Frame& F) {
    LAS float* scr = (LAS float*)(F.lds + F.wave * 16384);
    const int gw = F.vcu * NWAVES + F.wave, NGW = F.G * NWAVES, lane = F.lane;
    constexpr int I_IN = 32 * 200, I_OUT = 32 * 64, I_W1 = 64 * 32 * 16, I_W2 = 64 * 8 * 64, I_UP = 32, I_GUP = 64;
    constexpr int NITEMS = I_IN + I_OUT + 2 * I_W1 + I_W2 + 2 * I_UP + I_GUP;
    for (int it = gw; it < NITEMS; it += NGW) {
        int r = it;
        if (r < I_IN) { const int kb = r / 200, nb = r % 200; p0_transpose_item(F.w_in, INC, F.WIN, DM, 32 * nb, 64 * kb, 32 * nb, F.norm1_w, scr, lane); continue; } r -= I_IN;
        if (r < I_OUT) { const int kb = r / 64, nb = r % 64; p0_transpose_item(F.w_out, DM, F.WOUT, DM, 32 * nb, 64 * kb, 32 * nb, nullptr, scr, lane); continue; } r -= I_OUT;
        if (r < 2 * I_W1) { const int which = r / I_W1; r -= which * I_W1; const int e = r / 512, q = r % 512, kb = q / 16, nb = q % 16, n0 = 32 * nb;
            const float* W = (which ? F.moe_w3 : F.moe_w1) + (size_t)e * DM * DE;
            p0_transpose_item(W, DE, F.W13, DM, e * 1024 + (n0 >> 7) * 256 + which * 128 + (n0 & 127), 64 * kb, n0, nullptr, scr, lane); continue; } r -= 2 * I_W1;
        if (r < I_W2) { const int e = r / 512, q = r % 512, kb = q / 64, nb = q % 64;
            p0_transpose_item(F.moe_w2 + (size_t)e * DE * DM, DM, F.W2, DE, e * 2048 + 32 * nb, 64 * kb, 32 * nb, nullptr, scr, lane); continue; } r -= I_W2;
        if (r < I_UP) { p0_transpose_item(F.rw_w_up, 1024, F.WUP, 64, 32 * r, 0, 32 * r, nullptr, scr, lane); continue; } r -= I_UP;
        if (r < I_UP) { p0_transpose_item(F.rw_a_up, 1024, F.AUP, 64, 32 * r, 0, 32 * r, nullptr, scr, lane); continue; } r -= I_UP;
        { const int kb = r / 32, nb = r % 32; p0_transpose_item(F.rw_g_up, 1024, F.GUP, 128, 32 * nb, 64 * kb, 32 * nb, nullptr, scr, lane); }
    }
    for (int i = (F.vcu * NTHR + F.tid); i < 80 * DM; i += F.G * NTHR) { const int n = i / DM, k = i % DM;
        float v = 0.f; if (n < 8) v = F.rg_w[k * 8 + n]; else if (n < 72) v = F.re_w[k * 64 + (n - 8)];
        F.WRT[i] = v * F.norm2_w[k]; }
    for (int m = gw; m < T; m += NGW) {
        const f32x4* xr = (const f32x4*)(F.x + (size_t)m * DM) + lane;
        f32x4 v[8]; float s = 0.f;
#pragma unroll
        for (int j = 0; j < 8; ++j) { v[j] = xr[64 * j]; s += (v[j].x * v[j].x + v[j].y * v[j].y) + (v[j].z * v[j].z + v[j].w * v[j].w); }
        const float rs = 1.0f / sqrtf(wave_sum(s) * (1.0f / DM) + 1e-6f);
        unsigned long long* o8 = (unsigned long long*)(F.XN + (size_t)m * DM) + lane;
#pragma unroll
        for (int j = 0; j < 8; ++j) o8[64 * j] = (unsigned long long)pk2(v[j].x * rs, v[j].y * rs) | ((unsigned long long)pk2(v[j].z * rs, v[j].w * rs) << 32);
    }
}


constexpr int ST_TOK = 7 * 64;
constexpr int AT_PITCH = 264;
__device__ __forceinline__ void prep_unit(const Frame& F, int unit) {
    const int tid = F.tid, lane = F.lane, wave = F.wave;
    const int row0 = unit * 16, tpos0 = row0 & (SEQ - 1), bidx = row0 >> 12;
    bf16* Z = F.Z;
    {
        const int tk = tid >> 5, i = tid & 31;
        const float pos = (float)(tpos0 + tk);
        const float inv = exp2f(-(float)i * (13.287712379549449f / 32.0f));
        const float ang = pos * inv;
        const float sn = sinf(ang), cs = cosf(ang);
        bf16* zr = Z + (size_t)(row0 + tk) * INC;
#pragma unroll 4
        for (int hh = 0; hh < 32; ++hh) {
            const int col = hh * 64 + i;
            const float x1 = bf2f(zr[col]), x2 = bf2f(zr[col + 32]);
            float o1 = x1 * cs - x2 * sn, o2 = x2 * cs + x1 * sn;
            if (hh < 16) { o1 *= C2; o2 *= C2; }
            zr[col] = (bf16)f2bf(o1); zr[col + 32] = (bf16)f2bf(o2);
        }
    }
    LAS bf16* At = (LAS bf16*)F.lds;
    {
        const int tk = tid >> 5, c8 = (tid & 31) * 8;
        const bool first = (tpos0 + tk) == 0;
        const bf16* zc = Z + (size_t)(row0 + tk) * INC + ZR + 3072 + c8;
        const v4u cur = *(const v4u*)zc;
        v4u prv = (v4u){0u, 0u, 0u, 0u}; if (!first) prv = *(const v4u*)(zc - INC);
        const f32x4 mu0 = *(const f32x4*)(F.rw_mu + 3072 + c8), mu1 = *(const f32x4*)(F.rw_mu + 3072 + c8 + 4);
        float v[8];
#pragma unroll
        for (int j = 0; j < 4; ++j) { const float c0 = bflo(cur[j]), c1 = bfhi(cur[j]), p0 = bflo(prv[j]), p1 = bfhi(prv[j]);
            const float m0 = (j < 2) ? mu0[2 * j] : mu1[2 * j - 4], m1 = (j < 2) ? mu0[2 * j + 1] : mu1[2 * j - 3];
            v[2 * j] = c0 + (p0 - c0) * m0; v[2 * j + 1] = c1 + (p1 - c1) * m1; }
        if (c8 < 64) {
#pragma unroll
            for (int j = 0; j < 8; ++j) { const float e = __expf(2.0f * v[j]); v[j] = 1.0f - 2.0f * __builtin_amdgcn_rcpf(e + 1.0f); }
        } else if (c8 >= 128) {
#pragma unroll
            for (int j = 0; j < 8; ++j) v[j] = sigmoidf_(v[j]);
        }
        v4u o; o.x = pk2(v[0], v[1]); o.y = pk2(v[2], v[3]); o.z = pk2(v[4], v[5]); o.w = pk2(v[6], v[7]);
        *(LAS v4u*)(At + tk * AT_PITCH + c8) = o;
    }
    __syncthreads();
    const int l15 = lane & 15, l4 = lane >> 4;
    bf16x8 aW[2], aA[2], aG[4];
#pragma unroll
    for (int ks = 0; ks < 2; ++ks) { aW[ks] = *(const LAS bf16x8*)(At + l15 * AT_PITCH + ks * 32 + 8 * l4); aA[ks] = *(const LAS bf16x8*)(At + l15 * AT_PITCH + 64 + ks * 32 + 8 * l4); }
#pragma unroll
    for (int ks = 0; ks < 4; ++ks) aG[ks] = *(const LAS bf16x8*)(At + l15 * AT_PITCH + 128 + ks * 32 + 8 * l4);
    for (int hh = 0; hh < 2; ++hh) {
        const int h = wave * 2 + hh;
        float kkr[4][4], apv[4][4], ssq[4] = {0.f, 0.f, 0.f, 0.f}, bon[4] = {0.f, 0.f, 0.f, 0.f};
        bf16* sbase = F.STREAM + ((size_t)(bidx * 16 + h) * SEQ + tpos0) * ST_TOK;
#pragma unroll
        for (int nt = 0; nt < 4; ++nt) {
            const int c = h * 64 + nt * 16 + l15;
            f32x4 accW = (f32x4){0.f, 0.f, 0.f, 0.f}, accA = accW, accG = accW;
#pragma unroll
            for (int ks = 0; ks < 2; ++ks) {
                const bf16x8 bW = *(const bf16x8*)(F.WUP + (size_t)c * 64 + ks * 32 + 8 * l4);
                const bf16x8 bA = *(const bf16x8*)(F.AUP + (size_t)c * 64 + ks * 32 + 8 * l4);
                accW = __builtin_amdgcn_mfma_f32_16x16x32_bf16(aW[ks], bW, accW, 0, 0, 0);
                accA = __builtin_amdgcn_mfma_f32_16x16x32_bf16(aA[ks], bA, accA, 0, 0, 0);
            }
#pragma unroll
            for (int ks = 0; ks < 4; ++ks) {
                const bf16x8 bG = *(const bf16x8*)(F.GUP + (size_t)c * 128 + ks * 32 + 8 * l4);
                accG = __builtin_amdgcn_mfma_f32_16x16x32_bf16(aG[ks], bG, accG, 0, 0, 0);
            }
            const float mur = F.rw_mu[c], muk = F.rw_mu[1024 + c], muv = F.rw_mu[2048 + c];
            const float w0 = F.rw_w0[c], a0 = F.rw_a0[c], k_k = F.rw_k_k[c], k_a = F.rw_k_a[c], r_k = F.rw_r_k[c];
#pragma unroll
            for (int r = 0; r < 4; ++r) {
                const int tk = 4 * l4 + r;
                const bf16* zc = Z + (size_t)(row0 + tk) * INC + ZR + c;
                const bool first = (tpos0 + tk) == 0;
                float rc = bf2f(zc[0]), kc = bf2f(zc[1024]), vc = bf2f(zc[2048]);
                float rp = 0.f, kp = 0.f, vp = 0.f;
                if (!first) { rp = bf2f(zc[-INC]); kp = bf2f(zc[1024 - INC]); vp = bf2f(zc[2048 - INC]); }
                const float rv = rc + (rp - rc) * mur, kv = kc + (kp - kc) * muk, vv = vc + (vp - vc) * muv;
                const float sg = sigmoidf_(accW[r] + w0);
                const float xw = 1.0f - __expf(-0.6065306597126334f * sg);
                const float ap = sigmoidf_(accA[r] + a0);
                const float kr = kv * k_k;
                ssq[r] += kr * kr; kkr[nt][r] = kr; apv[nt][r] = ap;
                const float kprime = kv * (1.0f + (ap - 1.0f) * k_a);
                bon[r] += rv * kprime * r_k;
                bf16* sp = sbase + (size_t)tk * ST_TOK + nt * 16 + l15;
                sp[0 * 64] = (bf16)f2bf(rv); sp[1 * 64] = (bf16)f2bf(kprime); sp[2 * 64] = (bf16)f2bf(vv); sp[5 * 64] = (bf16)f2bf(xw); sp[6 * 64] = (bf16)f2bf(accG[r]);
            }
        }
#pragma unroll
        for (int r = 0; r < 4; ++r) { ssq[r] = reduce16(ssq[r]); bon[r] = reduce16(bon[r]); }
#pragma unroll
        for (int r = 0; r < 4; ++r) {
            const int tk = 4 * l4 + r;
            const float inv = 1.0f / fmaxf(sqrtf(ssq[r]), 1e-12f);
#pragma unroll
            for (int nt = 0; nt < 4; ++nt) { const float kk = kkr[nt][r] * inv; bf16* sp = sbase + (size_t)tk * ST_TOK + nt * 16 + l15;
                sp[3 * 64] = (bf16)f2bf(-kk); sp[4 * 64] = (bf16)f2bf(kk * apv[nt][r]); }
            if (l15 == 0) F.BONUS[(size_t)(bidx * 16 + h) * SEQ + tpos0 + tk] = bon[r];
        }
    }
    __syncthreads();
}


namespace att {
constexpr int L_K = 0, L_V = 16384, L_WS = 32768, L_XB = 36864;
typedef short v4i16_t __attribute__((ext_vector_type(4)));
__device__ __forceinline__ int crow(int r, int hi) { return (r & 3) + 8 * (r >> 2) + 4 * hi; }
__device__ __forceinline__ unsigned cvtpk(float lo, float hi) { typedef float f2 __attribute__((ext_vector_type(2))); typedef __bf16 b2 __attribute__((ext_vector_type(2)));
    f2 v = {lo, hi}; b2 b = __builtin_convertvector(v, b2); return __builtin_bit_cast(unsigned, b); }
__device__ __forceinline__ s16x4 vtr(const LAS char* p) { return __builtin_bit_cast(s16x4, __builtin_amdgcn_ds_read_tr16_b64_v4i16((LAS v4i16_t*)p)); }

__device__ __forceinline__ void attn_item(const Frame& F, int b, int hv, int qb, float lam) {
    const int tid = F.tid, lane = F.lane, wid = F.wave, r32 = lane & 31, hi = lane >> 5;
    const int hsel = wid >> 2, wq = wid & 3, hq = 2 * hv + hsel;
    const int q0 = qb * 128 + wq * 32;
    const bf16* Zb = F.Z + (size_t)b * SEQ * INC;
    LAS char* shm = (LAS char*)F.lds;
    LAS float* wsf = (LAS float*)(shm + L_WS) + wid * 64;
    bf16x8 qr[4];
#pragma unroll
    for (int d0 = 0; d0 < 4; ++d0) qr[d0] = *(const bf16x8*)(Zb + (size_t)(q0 + r32) * INC + hq * 64 + d0 * 16 + hi * 8);
    const int NT = 2 * qb + 2;
    const bf16* ksrc = Zb + (size_t)lane * INC + ZK + hv * 128 + wid * 16;
    const bf16* vsrc0 = Zb + (size_t)(16 * ((2 * wid) & 3) + (lane >> 2)) * INC + ZV + hv * 128 + ((2 * wid) >> 2) * 32 + (lane & 3) * 8;
    const bf16* vsrc1 = Zb + (size_t)(16 * ((2 * wid + 1) & 3) + (lane >> 2)) * INC + ZV + hv * 128 + ((2 * wid + 1) >> 2) * 32 + (lane & 3) * 8;
    LAS char* kdst = shm + L_K + (2 * wid) * 1024 + lane * 16;
    LAS char* vdst = shm + L_V + (2 * wid) * 1024 + lane * 16;
    v4u kreg0, kreg1, vreg0, vreg1;
    kreg0 = *(const v4u*)(ksrc); kreg1 = *(const v4u*)(ksrc + 8); vreg0 = *(const v4u*)vsrc0; vreg1 = *(const v4u*)vsrc1;
    float m = -1e30f, l = 0.f;
    f32x16 o[4];
#pragma unroll
    for (int d = 0; d < 4; ++d) o[d] = (f32x16){};
    const LAS char* kp = shm + L_K + hsel * 8192 + hi * 1024 + r32 * 16;
    const LAS char* vp = shm + L_V + ((lane >> 4) & 1) * 32 + (lane & 3) * 8 + (4 * hi + ((lane & 15) >> 2)) * 64;
    for (int t = 0; t < NT; ++t) {
        __syncthreads();
        *(LAS v4u*)(kdst) = kreg0; *(LAS v4u*)(kdst + 1024) = kreg1; *(LAS v4u*)(vdst) = vreg0; *(LAS v4u*)(vdst + 1024) = vreg1;
        if (t + 1 < NT) { const size_t adv = (size_t)(t + 1) * 64 * INC;
            kreg0 = *(const v4u*)(ksrc + adv); kreg1 = *(const v4u*)(ksrc + adv + 8); vreg0 = *(const v4u*)(vsrc0 + adv); vreg1 = *(const v4u*)(vsrc1 + adv); }
        __syncthreads();
        if (t * 64 <= q0 + 31) {
            f32x16 p0 = (f32x16){}, p1 = (f32x16){};
#pragma unroll
            for (int d0 = 0; d0 < 4; ++d0) {
                const bf16x8 k0 = *(const LAS bf16x8*)(kp + d0 * 2048), k1 = *(const LAS bf16x8*)(kp + d0 * 2048 + 512);
                p0 = __builtin_amdgcn_mfma_f32_32x32x16_bf16(k0, qr[d0], p0, 0, 0, 0);
                p1 = __builtin_amdgcn_mfma_f32_32x32x16_bf16(k1, qr[d0], p1, 0, 0, 0);
            }
            if (t >= NT - 2) {
                const int qpos = q0 + r32, kb = t * 64 + 4 * hi;
#pragma unroll
                for (int r = 0; r < 16; ++r) { const int kv = kb + (r & 3) + 8 * (r >> 2); if (kv > qpos) p0[r] = -1e30f; if (kv + 32 > qpos) p1[r] = -1e30f; }
            }
            float mx = fmaxf(p0[0], p1[0]);
#pragma unroll
            for (int r = 1; r < 16; ++r) mx = fmaxf(mx, fmaxf(p0[r], p1[r]));
            { auto rr = __builtin_amdgcn_permlane32_swap(__builtin_bit_cast(unsigned, mx), __builtin_bit_cast(unsigned, mx), false, false);
              mx = fmaxf(__builtin_bit_cast(float, rr[0]), __builtin_bit_cast(float, rr[1])); }
            const float mn = fmaxf(m, mx), f = __builtin_amdgcn_exp2f(m - mn); m = mn;
            float ps = 0.f;
#pragma unroll
            for (int r = 0; r < 16; ++r) { p0[r] = __builtin_amdgcn_exp2f(p0[r] - mn); p1[r] = __builtin_amdgcn_exp2f(p1[r] - mn); ps += p0[r] + p1[r]; }
            l = l * f + ps;
            if (hi == 0) wsf[r32] = f;
            v4u pw0, pw1, pw2, pw3;
            pw0.x = cvtpk(p0[0], p0[1]); pw0.y = cvtpk(p0[2], p0[3]); pw0.z = cvtpk(p0[4], p0[5]); pw0.w = cvtpk(p0[6], p0[7]);
            pw1.x = cvtpk(p0[8], p0[9]); pw1.y = cvtpk(p0[10], p0[11]); pw1.z = cvtpk(p0[12], p0[13]); pw1.w = cvtpk(p0[14], p0[15]);
            pw2.x = cvtpk(p1[0], p1[1]); pw2.y = cvtpk(p1[2], p1[3]); pw2.z = cvtpk(p1[4], p1[5]); pw2.w = cvtpk(p1[6], p1[7]);
            pw3.x = cvtpk(p1[8], p1[9]); pw3.y = cvtpk(p1[10], p1[11]); pw3.z = cvtpk(p1[12], p1[13]); pw3.w = cvtpk(p1[14], p1[15]);
            {
                float fr[16];
#pragma unroll
                for (int r = 0; r < 16; ++r) fr[r] = wsf[crow(r, hi)];
#pragma unroll
                for (int d = 0; d < 4; ++d)
#pragma unroll
                    for (int r = 0; r < 16; ++r) o[d][r] *= fr[r];
            }
#pragma unroll
            for (int d = 0; d < 4; ++d) {
                s16x4 lo[4], hh[4];
#pragma unroll
                for (int ks = 0; ks < 4; ++ks) { lo[ks] = vtr(vp + d * 4096 + ks * 1024); hh[ks] = vtr(vp + d * 4096 + ks * 1024 + 512); }
#define ATT_VF(k) (bf16x8){lo[k][0], lo[k][1], lo[k][2], lo[k][3], hh[k][0], hh[k][1], hh[k][2], hh[k][3]}
                o[d] = __builtin_amdgcn_mfma_f32_32x32x16_bf16(__builtin_bit_cast(bf16x8, pw0), ATT_VF(0), o[d], 0, 0, 0);
                o[d] = __builtin_amdgcn_mfma_f32_32x32x16_bf16(__builtin_bit_cast(bf16x8, pw1), ATT_VF(1), o[d], 0, 0, 0);
                o[d] = __builtin_amdgcn_mfma_f32_32x32x16_bf16(__builtin_bit_cast(bf16x8, pw2), ATT_VF(2), o[d], 0, 0, 0);
                o[d] = __builtin_amdgcn_mfma_f32_32x32x16_bf16(__builtin_bit_cast(bf16x8, pw3), ATT_VF(3), o[d], 0, 0, 0);
#undef ATT_VF
            }
        }
    }
    { auto rr = __builtin_amdgcn_permlane32_swap(__builtin_bit_cast(unsigned, l), __builtin_bit_cast(unsigned, l), false, false);
      l = __builtin_bit_cast(float, rr[0]) + __builtin_bit_cast(float, rr[1]); }
    if (hi == 0) wsf[32 + r32] = (hsel ? lam : 1.0f) / l;
    {
        float rl[16];
#pragma unroll
        for (int r = 0; r < 16; ++r) rl[r] = wsf[32 + crow(r, hi)];
#pragma unroll
        for (int d = 0; d < 4; ++d)
#pragma unroll
            for (int r = 0; r < 16; ++r) o[d][r] *= rl[r];
    }
    LAS float* xb = (LAS float*)(shm + L_XB) + wq * 4096 + lane;
    if (hsel) {
#pragma unroll
        for (int d = 0; d < 4; ++d)
#pragma unroll
            for (int r = 0; r < 16; ++r) xb[(d * 16 + r) * 64] = o[d][r];
    }
    __syncthreads();
    if (!hsel) {
        float ss[16];
#pragma unroll
        for (int r = 0; r < 16; ++r) ss[r] = 0.f;
#pragma unroll
        for (int d = 0; d < 4; ++d)
#pragma unroll
            for (int r = 0; r < 16; ++r) { o[d][r] -= xb[(d * 16 + r) * 64]; ss[r] += o[d][r] * o[d][r]; }
        float sw[4];
#pragma unroll
        for (int d = 0; d < 4; ++d) sw[d] = F.subln_w[d * 32 + r32] * (1.0f - LAM_INIT);
#pragma unroll
        for (int r = 0; r < 16; ++r) {
            float s = reduce16(ss[r]); s += __shfl_xor(s, 16);
            const float rs = 1.0f / sqrtf(s * (1.0f / 128.0f) + 1e-5f);
            bf16* orow = F.MIX + (size_t)(b * SEQ + q0 + crow(r, hi)) * DM + hv * 128 + r32;
#pragma unroll
            for (int d = 0; d < 4; ++d) orow[d * 32] = (bf16)f2bf(o[d][r] * rs * sw[d]);
        }
    }
}
}


namespace scan {
constexpr int L_CB = 0, L_GB = 49152, L_YB = 57344, CH = 32;
__device__ __forceinline__ void scan_item(const Frame& F, int bh) {
    const int tid = F.tid, p = tid >> 4, q = tid & 15;
    const int b = bh >> 4, h = bh & 15;
    LAS float* CB = (LAS float*)(F.lds + L_CB); LAS float* GB = (LAS float*)(F.lds + L_GB); LAS float* YB = (LAS float*)(F.lds + L_YB);
    const bf16* sbase = F.STREAM + (size_t)bh * SEQ * ST_TOK;
    const float* bonus = F.BONUS + (size_t)bh * SEQ;
    float s0[4] = {0.f, 0.f, 0.f, 0.f}, s1[4] = {0.f, 0.f, 0.f, 0.f};
    v4u pf[4];
#pragma unroll
    for (int i = 0; i < 4; ++i) { const int pid = tid + 512 * i; if (pid < 1792) pf[i] = *(const v4u*)(sbase + (size_t)pid * 8); }
    const f32x4 lw = *(const f32x4*)(F.rw_lnx_w + h * 64 + 4 * q), lb = *(const f32x4*)(F.rw_lnx_b + h * 64 + 4 * q);
    for (int c = 0; c < SEQ / CH; ++c) {
        __syncthreads();
#pragma unroll
        for (int i = 0; i < 4; ++i) { const int pid = tid + 512 * i;
            if (pid < 1792) { const int tok = pid / 56, rem = pid - tok * 56, arr = rem >> 3, j8 = (rem & 7) * 8;
                float v[8];
#pragma unroll
                for (int j = 0; j < 4; ++j) { v[2 * j] = bflo(pf[i][j]); v[2 * j + 1] = bfhi(pf[i][j]); }
                if (arr == 5) {
#pragma unroll
                    for (int j = 0; j < 8; ++j) v[j] = 1.0f - v[j];
                }
                LAS float* dst = (arr < 6) ? (CB + tok * 384 + arr * 64 + j8) : (GB + tok * 64 + j8);
                *(LAS f32x4*)dst = (f32x4){v[0], v[1], v[2], v[3]}; *(LAS f32x4*)(dst + 4) = (f32x4){v[4], v[5], v[6], v[7]}; } }
        if (c + 1 < SEQ / CH) {
#pragma unroll
            for (int i = 0; i < 4; ++i) { const int pid = tid + 512 * i; if (pid < 1792) pf[i] = *(const v4u*)(sbase + (size_t)(c + 1) * CH * ST_TOK + (size_t)pid * 8); }
        }
        const float bon = bonus[c * CH + p];
        __syncthreads();
#pragma unroll 4
        for (int tt = 0; tt < CH; ++tt) {
            const LAS float* cb = CB + tt * 384;
            const f32x4 r4 = *(const LAS f32x4*)(cb + 4 * q), k4 = *(const LAS f32x4*)(cb + 64 + 4 * q), a4 = *(const LAS f32x4*)(cb + 192 + 4 * q),
                        b4 = *(const LAS f32x4*)(cb + 256 + 4 * q), w4 = *(const LAS f32x4*)(cb + 320 + 4 * q);
            const float v0 = cb[128 + 2 * p], v1 = cb[128 + 2 * p + 1];
            float sa0 = (s0[0] * a4[0] + s0[1] * a4[1]) + (s0[2] * a4[2] + s0[3] * a4[3]);
            float sa1 = (s1[0] * a4[0] + s1[1] * a4[1]) + (s1[2] * a4[2] + s1[3] * a4[3]);
            sa0 = reduce16(sa0); sa1 = reduce16(sa1);
#pragma unroll
            for (int j = 0; j < 4; ++j) { s0[j] = fmaf(sa0, b4[j], fmaf(s0[j], w4[j], v0 * k4[j])); s1[j] = fmaf(sa1, b4[j], fmaf(s1[j], w4[j], v1 * k4[j])); }
            float y0 = (s0[0] * r4[0] + s0[1] * r4[1]) + (s0[2] * r4[2] + s0[3] * r4[3]);
            float y1 = (s1[0] * r4[0] + s1[1] * r4[1]) + (s1[2] * r4[2] + s1[3] * r4[3]);
            y0 = reduce16(y0); y1 = reduce16(y1);
            if (q == 0) { YB[tt * 64 + 2 * p] = y0; YB[tt * 64 + 2 * p + 1] = y1; }
        }
        __syncthreads();
        {
            const f32x4 y4 = *(const LAS f32x4*)(YB + p * 64 + 4 * q);
            const float mean = reduce16((y4[0] + y4[1]) + (y4[2] + y4[3])) * (1.0f / 64.0f);
            const f32x4 d4 = y4 - mean;
            const float var = reduce16((d4[0] * d4[0] + d4[1] * d4[1]) + (d4[2] * d4[2] + d4[3] * d4[3])) * (1.0f / 64.0f);
            const float rs = 1.0f / sqrtf(var + 64e-5f);
            const f32x4 v4 = *(const LAS f32x4*)(CB + p * 384 + 128 + 4 * q), g4 = *(const LAS f32x4*)(GB + p * 64 + 4 * q);
            f32x4 o = (d4 * rs * lw + lb + v4 * bon) * g4;
            v2u w; w.x = pk2(o[0], o[1]); w.y = pk2(o[2], o[3]);
            *(v2u*)(F.MIX + (size_t)(b * SEQ + c * CH + p) * DM + 1024 + h * 64 + 4 * q) = w;
        }
    }
}
}

__device__ __forceinline__ void p3_mix(const Frame& F) {
    float lam;
    { float d1 = 0.f, d2 = 0.f;
      for (int i = 0; i < 64; ++i) { d1 += F.lam_q1[i] * F.lam_k1[i]; d2 += F.lam_q2[i] * F.lam_k2[i]; }
      lam = __expf(d1) - __expf(d2) + LAM_INIT; }
    for (;;) {
        if (F.tid == 0) F.MISC[0] = atomicAdd(F.ctl + CW_QHEAD, 1u);
        __syncthreads();
        const int id = (int)__builtin_amdgcn_readfirstlane(F.MISC[0]);
        __syncthreads();
        if (id >= 64 + 1024) break;
        if (id < 64) scan::scan_item(F, id);
        else { const int a = id - 64; const int qb = 31 - (a >> 5), bhv = a & 31; att::attn_item(F, bhv >> 3, bhv & 7, qb, lam); }
    }
}


__device__ __forceinline__ void router_tile(const Frame& F, int tile) {
    const int lane = F.lane, wid = F.wave, blk = wid & 3, kh = wid >> 2, l15 = lane & 15, l4 = lane >> 4;
    LAS float* xb = (LAS float*)F.lds;
    LAS float* lg = (LAS float*)(F.lds + 32768);
    const float* hrow = F.out + (size_t)(tile * 64 + blk * 16 + l15) * DM + kh * 1024 + 4 * l4;
    const float* wrow = F.WRT + (size_t)l15 * DM + kh * 1024 + 4 * l4;
    f32x4 acc[5];
#pragma unroll
    for (int nb = 0; nb < 5; ++nb) acc[nb] = (f32x4){0.f, 0.f, 0.f, 0.f};
    float ssq = 0.f;
#pragma unroll 2
    for (int s = 0; s < 64; ++s) {
        const f32x4 a = *(const f32x4*)(hrow + s * 16);
        f32x4 bq[5];
#pragma unroll
        for (int nb = 0; nb < 5; ++nb) bq[nb] = *(const f32x4*)(wrow + (size_t)nb * 16 * DM + s * 16);
        ssq += (a[0] * a[0] + a[1] * a[1]) + (a[2] * a[2] + a[3] * a[3]);
#pragma unroll
        for (int e = 0; e < 4; ++e)
#pragma unroll
            for (int nb = 0; nb < 5; ++nb) acc[nb] = __builtin_amdgcn_mfma_f32_16x16x4f32(a[e], bq[nb][e], acc[nb], 0, 0, 0);
    }
    ssq += __shfl_xor(ssq, 16); ssq += __shfl_xor(ssq, 32);
    __syncthreads();
    if (kh == 1) {
#pragma unroll
        for (int nb = 0; nb < 5; ++nb)
#pragma unroll
            for (int r = 0; r < 4; ++r) xb[(blk * 21 + nb * 4 + r) * 64 + lane] = acc[nb][r];
        xb[(blk * 21 + 20) * 64 + lane] = ssq;
    }
    __syncthreads();
    if (kh == 0) {
#pragma unroll
        for (int nb = 0; nb < 5; ++nb)
#pragma unroll
            for (int r = 0; r < 4; ++r) lg[(blk * 16 + 4 * l4 + r) * 81 + nb * 16 + l15] = acc[nb][r] + xb[(blk * 21 + nb * 4 + r) * 64 + lane];
        if (l4 == 0) lg[(blk * 16 + l15) * 81 + 80] = ssq + xb[(blk * 21 + 20) * 64 + lane];
    }
    __syncthreads();
    if (kh == 0 && lane < 16) {
        const int t = tile * 64 + blk * 16 + lane;
        const LAS float* L = lg + (blk * 16 + lane) * 81;
        const float r2 = 1.0f / sqrtf(L[80] * (1.0f / DM) + 1e-6f);
        float gl[8]; float gm = -3.0e38f; int gs = 0;
#pragma unroll
        for (int i = 0; i < 8; ++i) { gl[i] = L[i] * r2 + F.rg_b[i]; if (gl[i] > gm) { gm = gl[i]; gs = i; } }
        float gsum = 0.f;
#pragma unroll
        for (int i = 0; i < 8; ++i) gsum += __expf(gl[i] - gm);
        const float pg = 1.0f / gsum;
        float el[8]; float m0 = -3.0e38f, m1 = -3.0e38f; int i0 = 0, i1 = 0;
        for (int i = 0; i < 8; ++i) { el[i] = L[8 + gs * 8 + i] * r2 + F.re_b[gs * 8 + i]; }
#pragma unroll
        for (int i = 0; i < 8; ++i) { if (el[i] > m0) { m1 = m0; i1 = i0; m0 = el[i]; i0 = i; } else if (el[i] > m1) { m1 = el[i]; i1 = i; } }
        const float e1 = __expf(m1 - m0);
        const float g0 = pg / (1.0f + e1), g1 = pg * e1 / (1.0f + e1);
        const int x0 = gs * 8 + i0, x1 = gs * 8 + i1;
        const int rk0 = (int)atomicAdd(F.ctl + CW_CNT + x0, 1u), rk1 = (int)atomicAdd(F.ctl + CW_CNT + x1, 1u);
        F.ROUTE_E[2 * t] = x0; F.ROUTE_E[2 * t + 1] = x1; F.ROUTE_R[2 * t] = rk0; F.ROUTE_R[2 * t + 1] = rk1;
        F.ROUTE_G[2 * t] = g0; F.ROUTE_G[2 * t + 1] = g1; F.R2[t] = r2;
    }
}
__device__ __forceinline__ void p6_gather(const Frame& F) {
    LAS int* tb = (LAS int*)F.lds;
    __syncthreads();
    if (F.tid == 0) { int acc = 0; for (int e = 0; e < NE; ++e) { tb[e] = acc; const int cnt = (int)__hip_atomic_load(F.ctl + CW_CNT + e, __ATOMIC_RELAXED, __HIP_MEMORY_SCOPE_AGENT); acc += (cnt + 255) >> 8; } tb[NE] = acc; }
    __syncthreads();
    if (blockIdx.x == 0) {
        if (F.tid < NE) { const int lo = tb[F.tid], hi = tb[F.tid + 1]; for (int i = lo; i < hi; ++i) F.TILEE[i] = F.tid; }
        if (F.tid == 0) F.ctl[CW_NT] = (unsigned)tb[NE];
    }
    const int gw = F.vcu * NWAVES + F.wave, NGW = F.G * NWAVES, lane = F.lane;
    f32x4 nw[8];
#pragma unroll
    for (int j = 0; j < 8; ++j) nw[j] = ((const f32x4*)F.norm2_w)[64 * j + lane];
    for (int t = gw; t < T; t += NGW) {
        const int e0 = F.ROUTE_E[2 * t], e1 = F.ROUTE_E[2 * t + 1];
        const int s0 = tb[e0] * 256 + F.ROUTE_R[2 * t], s1 = tb[e1] * 256 + F.ROUTE_R[2 * t + 1];
        const float r2 = F.R2[t];
        const f32x4* hr = (const f32x4*)(F.out + (size_t)t * DM) + lane;
        unsigned long long* o0 = (unsigned long long*)(F.XG + (size_t)s0 * DM) + lane;
        unsigned long long* o1 = (unsigned long long*)(F.XG + (size_t)s1 * DM) + lane;
#pragma unroll
        for (int j = 0; j < 8; ++j) { const f32x4 v = hr[64 * j] * r2 * nw[j];
            const unsigned long long w = (unsigned long long)pk2(v[0], v[1]) | ((unsigned long long)pk2(v[2], v[3]) << 32);
            o0[64 * j] = w; o1[64 * j] = w; }
        if (lane == 0) { F.SLOT[2 * t] = s0; F.SLOT[2 * t + 1] = s1; }
    }
}
__device__ __forceinline__ void p9_final(const Frame& F) {
    const int gw = F.vcu * NWAVES + F.wave, NGW = F.G * NWAVES, lane = F.lane;
    f32x4 fw[8];
#pragma unroll
    for (int j = 0; j < 8; ++j) fw[j] = ((const f32x4*)F.final_w)[64 * j + lane];
    for (int t = gw; t < T; t += NGW) {
        const int s0 = F.SLOT[2 * t], s1 = F.SLOT[2 * t + 1];
        const float g0 = F.ROUTE_G[2 * t], g1 = F.ROUTE_G[2 * t + 1];
        f32x4* hr = (f32x4*)(F.out + (size_t)t * DM) + lane;
        const v2u* y0 = (const v2u*)(F.Y + (size_t)s0 * DM) + lane;
        const v2u* y1 = (const v2u*)(F.Y + (size_t)s1 * DM) + lane;
        f32x4 v[8]; float ss = 0.f;
#pragma unroll
        for (int j = 0; j < 8; ++j) { const v2u a = y0[64 * j], c = y1[64 * j];
            const f32x4 ya = (f32x4){bflo(a.x), bfhi(a.x), bflo(a.y), bfhi(a.y)}, yc = (f32x4){bflo(c.x), bfhi(c.x), bflo(c.y), bfhi(c.y)};
            v[j] = hr[64 * j] + ya * g0 + yc * g1;
            ss += (v[j][0] * v[j][0] + v[j][1] * v[j][1]) + (v[j][2] * v[j][2] + v[j][3] * v[j][3]); }
        const float rs = 1.0f / sqrtf(wave_sum(ss) * (1.0f / DM) + 1e-6f);
#pragma unroll
        for (int j = 0; j < 8; ++j) hr[64 * j] = v[j] * rs * fw[j];
    }
}


struct Args { const float* in[29]; float* out; unsigned char* ws; int ph_lo, ph_hi; };
__global__ void __launch_bounds__(NTHR, 2) hybrid_fwd(Args args) {
    extern __shared__ __attribute__((aligned(16))) unsigned char lds[];
    Frame F;
    F.lds = (LAS unsigned char*)lds;
    F.MISC = (volatile LAS unsigned*)(F.lds + MISC_OFF);
    F.tid = threadIdx.x; F.lane = F.tid & 63; F.wave = __builtin_amdgcn_readfirstlane(F.tid >> 6);
    F.G = gridDim.x; { const int bx = blockIdx.x; F.vcu = (F.G % 8 == 0) ? (bx % 8) * (F.G / 8) + bx / 8 : bx; }
    unsigned char* ws = args.ws;
    F.ctl = (unsigned*)(ws + WS_CTL);
    F.x = args.in[0]; F.norm1_w = args.in[1]; F.w_in = args.in[2]; F.lam_q1 = args.in[3]; F.lam_k1 = args.in[4]; F.lam_q2 = args.in[5]; F.lam_k2 = args.in[6]; F.subln_w = args.in[7];
    F.rw_mu = args.in[8]; F.rw_w0 = args.in[9]; F.rw_w_up = args.in[10]; F.rw_a0 = args.in[11]; F.rw_a_up = args.in[12]; F.rw_g_up = args.in[13]; F.rw_k_k = args.in[14]; F.rw_k_a = args.in[15];
    F.rw_r_k = args.in[16]; F.rw_lnx_w = args.in[17]; F.rw_lnx_b = args.in[18]; F.w_out = args.in[19]; F.norm2_w = args.in[20]; F.rg_w = args.in[21]; F.rg_b = args.in[22]; F.re_w = args.in[23];
    F.re_b = args.in[24]; F.moe_w1 = args.in[25]; F.moe_w3 = args.in[26]; F.moe_w2 = args.in[27]; F.final_w = args.in[28];
    F.out = args.out;
    F.WIN = (bf16*)(ws + WS_WIN); F.WOUT = (bf16*)(ws + WS_WOUT); F.W13 = (bf16*)(ws + WS_W13); F.W2 = (bf16*)(ws + WS_W2);
    F.XN = (bf16*)(ws + WS_XN); F.MIX = (bf16*)(ws + WS_XN); F.Z = (bf16*)(ws + WS_Z); F.XG = (bf16*)(ws + WS_Z);
    F.STREAM = (bf16*)(ws + WS_STREAM); F.Y = (bf16*)(ws + WS_STREAM); F.HID = (bf16*)(ws + WS_HID);
    unsigned char* sm = ws + WS_SMALL;
    F.WUP = (bf16*)(sm + SM_WUP); F.AUP = (bf16*)(sm + SM_AUP); F.GUP = (bf16*)(sm + SM_GUP); F.WRT = (float*)(sm + SM_WRT); F.BONUS = (float*)(sm + SM_BONUS);
    F.ROUTE_E = (int*)(sm + SM_ROUTE_E); F.ROUTE_R = (int*)(sm + SM_ROUTE_R); F.ROUTE_G = (float*)(sm + SM_ROUTE_G); F.R2 = (float*)(sm + SM_R2); F.SLOT = (int*)(sm + SM_SLOT); F.TILEE = (int*)(sm + SM_TILEE);

    const int lo = args.ph_lo, hi = args.ph_hi;
#define IN(k) (lo <= (k) && (k) < hi)
#define SEAM(k) do { if (IN(k) && IN((k) + 1)) { cg::this_grid().sync(); } } while (0)

    if (IN(0)) { p0_prologue(F); SEAM(0); }
    if (IN(1)) {
        pg8::Gemm g{F.XN, F.WIN, T, INC, DM}; pg8::StaticOrder S; S.init(T, INC, F.G, (int)blockIdx.x);
        pg8::EpiBf16<0> E{F.Z, INC, nullptr, 0, 0, 1.0f};
        pg8::gemm_phase<pg8::EpiBf16<0>, pg8::StaticOrder, true, true>(F.lds, g, S, E);
        SEAM(1);
    }
    if (IN(2)) { for (int u = F.vcu; u < T / 16; u += F.G) prep_unit(F, u); SEAM(2); }
    if (IN(3)) { p3_mix(F); SEAM(3); }
    if (IN(4)) {
        pg8::Gemm g{F.MIX, F.WOUT, T, DM, DM}; pg8::StaticOrder S; S.init(T, DM, F.G, (int)blockIdx.x);
        pg8::EpiF32Res E{F.x, F.out, DM};
        pg8::gemm_phase<pg8::EpiF32Res, pg8::StaticOrder, true, true>(F.lds, g, S, E);
        SEAM(4);
    }
    if (IN(5)) { for (int tl = F.vcu; tl < T / 64; tl += F.G) router_tile(F, tl); SEAM(5); }
    if (IN(6)) { p6_gather(F); SEAM(6); }
    if (IN(7)) {
        const int nT = __builtin_amdgcn_readfirstlane((int)__hip_atomic_load(F.ctl + CW_NT, __ATOMIC_RELAXED, __HIP_MEMORY_SCOPE_AGENT));
        pg8::Gemm g{F.XG, F.W13, PMAX, NE * 1024, DM}; pg8::MoeOrder S{F.TILEE, nT * 4, 4, F.G, (int)blockIdx.x};
        pg8::EpiSwiGLU E{F.HID};
        pg8::gemm_phase<pg8::EpiSwiGLU, pg8::MoeOrder, true, true>(F.lds, g, S, E);
        SEAM(7);
    }
    if (IN(8)) {
        const int nT = __builtin_amdgcn_readfirstlane((int)__hip_atomic_load(F.ctl + CW_NT, __ATOMIC_RELAXED, __HIP_MEMORY_SCOPE_AGENT));
        pg8::Gemm g{F.HID, F.W2, PMAX, NE * 2048, DE}; pg8::MoeOrder S{F.TILEE, nT * 8, 8, F.G, (int)blockIdx.x};
        pg8::EpiBf16<0> E{F.Y, DM, nullptr, 2048, 0, 1.0f};
        pg8::gemm_phase<pg8::EpiBf16<0>, pg8::MoeOrder, true, true>(F.lds, g, S, E);
        SEAM(8);
    }
    if (IN(9)) { p9_final(F); }
#undef IN
#undef SEAM
}

extern "C" void kernel_launch(void* const* d_in, const int* in_sizes, int n_in, void* d_out, int out_size, void* d_ws, size_t ws_size, hipStream_t stream) {
    static int grid = 0;
    if (grid == 0) {
        if (n_in != 29 || in_sizes[0] != T * DM || out_size != T * DM || ws_size < WS_END) {
            fprintf(stderr, "kernel_launch: unexpected shapes (n_in %d, in0 %d, out %d, ws %zu; need ws >= %zu); nothing launched\n", n_in, n_in > 0 ? in_sizes[0] : -1, out_size, ws_size, (size_t)WS_END);
            grid = -1; return; }
        int dev = 0, cus = 0, per_cu = 0;
        if (hipGetDevice(&dev) != hipSuccess || hipDeviceGetAttribute(&cus, hipDeviceAttributeMultiprocessorCount, dev) != hipSuccess) { fprintf(stderr, "kernel_launch: device query failed\n"); grid = -1; return; }
        if (hipFuncSetAttribute((const void*)hybrid_fwd, hipFuncAttributeMaxDynamicSharedMemorySize, LDS_BYTES) != hipSuccess) { fprintf(stderr, "kernel_launch: hipFuncSetAttribute failed\n"); grid = -1; return; }
        if (hipOccupancyMaxActiveBlocksPerMultiprocessor(&per_cu, (const void*)hybrid_fwd, NTHR, LDS_BYTES) != hipSuccess || per_cu < 1) {
            fprintf(stderr, "kernel_launch: occupancy query reports %d blocks per CU\n", per_cu); (void)hipGetLastError(); per_cu = 1; }
        grid = cus;
        fprintf(stderr, "kernel_launch: grid %d (per_cu query %d), launches %d\n", grid, per_cu, N_LAUNCHES);
    }
    if (grid < 0) return;
    (void)hipMemsetAsync((char*)d_ws + WS_CTL, 0, CTL_ZERO_BYTES, stream);
    Args a{};
    for (int i = 0; i < 29; ++i) a.in[i] = (const float*)d_in[i];
    a.out = (float*)d_out; a.ws = (unsigned char*)d_ws;
    if (N_LAUNCHES == 1) {
        a.ph_lo = 0; a.ph_hi = NPHASE;
        void* kargs[] = {&a};
        hipError_t e = hipLaunchCooperativeKernel((const void*)hybrid_fwd, dim3(grid), dim3(NTHR), kargs, LDS_BYTES, stream);
        if (e != hipSuccess) fprintf(stderr, "kernel_launch: cooperative launch failed: %s (grid %d)\n", hipGetErrorString(e), grid);
    } else {
        for (int ph = 0; ph < NPHASE; ++ph) {
            a.ph_lo = ph; a.ph_hi = ph + 1;
            hipLaunchKernelGGL(hybrid_fwd, dim3(grid), dim3(NTHR), LDS_BYTES, stream, a);
            const hipError_t le = hipPeekAtLastError();
            if (le != hipSuccess) { fprintf(stderr, "kernel_launch: launch %d failed: %s\n", ph, hipGetErrorName(le)); break; }
        }
    }
}
```

```cpp
#include <hip/hip_runtime.h>
#include <hip/hip_cooperative_groups.h>
#include <cstdio>
#include <cstdint>
#include <cmath>
namespace cg = cooperative_groups;

#ifndef MK_N_LAUNCHES
#define MK_N_LAUNCHES 1
#endif

#ifndef DUP_PHASE
#define DUP_PHASE -1
#endif

#ifndef STALL_PHASE
#define STALL_PHASE -1
#endif

namespace pg8 {
#define PG8_LAS __attribute__((address_space(3)))
typedef unsigned short bf16_t;
typedef short bf16x8 __attribute__((ext_vector_type(8)));
typedef float f32x4 __attribute__((ext_vector_type(4)));
typedef unsigned u32x4 __attribute__((ext_vector_type(4)));
constexpr int BM = 256, BK = 64, HALF = 128, HTB = HALF * BK * 2  , STAGE_BYTES = 8 * HTB, NXCD = 8, WGM = 8;

__host__ __device__ __forceinline__ int lds_byte(int r, int c) { const int st = (r >> 4) * 2 + (c >> 5), rr = r & 15, cc = c & 31, ob = rr * 64 + cc * 2; return st * 1024 + (ob ^ (((ob >> 9) & 1) << 5)); }
__host__ __device__ __forceinline__ void stage_rc(int b, int& R, int& C) { const int st = b / 1024, sb = b % 1024, swz = sb ^ (((sb >> 9) & 1) << 5); R = (st >> 1) * 16 + swz / 64; C = (st & 1) * 32 + (swz % 64) / 2; }
__host__ __device__ __forceinline__ int perm32(int rho) { const int n = rho >> 4, i = rho & 15; return 8 * (i >> 2) + 4 * n + (i & 3); }

struct Unit { int pm, pn; };
struct Gemm { const bf16_t* A; const bf16_t* Bt; int M, N, K; };

struct StaticOrder {
    int nM, nN, nwg, G, c;
    __host__ __device__ void init(int M, int N, int G_, int c_) { nM = M / BM; nN = N / BM; nwg = nM * nN; G = G_; c = c_; }
    __host__ __device__ bool next(int i, Unit& u) const {
        const long L = (long)i * G + c; if (L >= nwg) return false;
        int wgid = (int)L; { const int q = nwg / NXCD, r = nwg % NXCD, xcd = wgid % NXCD, off = wgid / NXCD; wgid = (xcd < r ? xcd * (q + 1) : r * (q + 1) + (xcd - r) * q) + off; }
        const int nig = WGM * nN, gid = wgid / nig, fm = gid * WGM, gsz = (nM - fm) < WGM ? (nM - fm) : WGM;
        u.pm = fm + ((wgid % nig) % gsz); u.pn = (wgid % nig) / gsz; return true;
    }
    __device__ __forceinline__ void a_ready(const Unit&) const {}
    __device__ __forceinline__ void done(const Unit&) const {}
};

__device__ __forceinline__ unsigned cvt_pk_bf16(float lo, float hi) { unsigned r; asm volatile("v_cvt_pk_bf16_f32 %0, %1, %2" : "=v"(r) : "v"(lo), "v"(hi)); return r; }
typedef float f32x2 __attribute__((ext_vector_type(2)));
__device__ __forceinline__ f32x2 gelu_pk(f32x2 v) {
    const f32x2 av = __builtin_elementwise_abs(v), d = av * 0.2316418882f + 1.0f;
    f32x2 t; t.x = __builtin_amdgcn_rcpf(d.x); t.y = __builtin_amdgcn_rcpf(d.y);
    f32x2 q = t * 0.5307027145f + (-0.7265760135f); q = q * t + 0.7107068705f; q = q * t + (-0.142248368f); q = q * t + 0.127414796f; q = q * t;
    const f32x2 s = (v * v) * (-0.72134752044f);
    f32x2 e; e.x = __builtin_amdgcn_exp2f(s.x); e.y = __builtin_amdgcn_exp2f(s.y);
    const f32x2 m = v * (q * e), r = v - m;
    f32x2 o; o.x = v.x < 0.f ? m.x : r.x; o.y = v.y < 0.f ? m.y : r.y; return o;
}

template <int ACT  > struct EpiBf16 {
    static constexpr bool PERM = true, AFTER_DRAIN = false; static_assert(ACT == 0 || ACT == 1, "EpiBf16: ACT is 0 (none) or 1 (gelu_pk)");
    bf16_t* O; int ldc; const float* bias; int split_cols; size_t split_stride; float scale0;
    __device__ __forceinline__ void operator()(const f32x4 (&acc)[2][2][4][2], const Unit& u, int wr, int wc, int fr, int fq) const {
        const int row0 = u.pm * BM + wr * 64 + fr; int colt = u.pn * BM; bf16_t* base = O;
        float sc = 1.f; if (split_cols) { const int t = colt / split_cols; base += (size_t)t * split_stride; colt -= t * split_cols; if (t == 0) sc = scale0; }
        const int col0 = colt + wc * 32 + 8 * fq, bcol0 = u.pn * BM + wc * 32 + 8 * fq;
        f32x4 bv[2][2];
#pragma unroll
        for (int bj = 0; bj < 2; ++bj)
#pragma unroll
            for (int n = 0; n < 2; ++n) bv[bj][n] = bias ? *(const f32x4*)(bias + bcol0 + bj * HALF + 4 * n) : (f32x4){0.f, 0.f, 0.f, 0.f};
#pragma unroll
        for (int ai = 0; ai < 2; ++ai)
#pragma unroll
            for (int m = 0; m < 4; ++m) { bf16_t* rowp = base + (size_t)(row0 + ai * HALF + m * 16) * ldc + col0;
#pragma unroll
                for (int bj = 0; bj < 2; ++bj) { f32x4 v0 = acc[ai][bj][m][0] + bv[bj][0], v1 = acc[ai][bj][m][1] + bv[bj][1];
                    if (ACT == 1) { f32x2 a = gelu_pk((f32x2){v0[0], v0[1]}), b = gelu_pk((f32x2){v0[2], v0[3]}), c = gelu_pk((f32x2){v1[0], v1[1]}), d = gelu_pk((f32x2){v1[2], v1[3]});
                        v0 = (f32x4){a.x, a.y, b.x, b.y}; v1 = (f32x4){c.x, c.y, d.x, d.y}; }
                    v0 = v0 * sc; v1 = v1 * sc; u32x4 w; w.x = cvt_pk_bf16(v0[0], v0[1]); w.y = cvt_pk_bf16(v0[2], v0[3]); w.z = cvt_pk_bf16(v1[0], v1[1]); w.w = cvt_pk_bf16(v1[2], v1[3]);
                    *(u32x4*)(rowp + bj * HALF) = w; } }
    }
};

struct EpiF32Res {
    static constexpr bool PERM = false, AFTER_DRAIN = false;
    const float* base; float* out; int ldc;
    __device__ __forceinline__ void operator()(const f32x4 (&acc)[2][2][4][2], const Unit& u, int wr, int wc, int fr, int fq) const {
        const int row0 = u.pm * BM + wr * 64 + fr, col0 = u.pn * BM + wc * 32 + 4 * fq;
#pragma unroll
        for (int ai = 0; ai < 2; ++ai)
#pragma unroll
            for (int m = 0; m < 4; ++m) { const size_t off = (size_t)(row0 + ai * HALF + m * 16) * ldc + col0;
#pragma unroll
                for (int bj = 0; bj < 2; ++bj)
#pragma unroll
                    for (int n = 0; n < 2; ++n) { const f32x4 bs = *(const f32x4*)(base + off + bj * HALF + n * 16); *(f32x4*)(out + off + bj * HALF + n * 16) = bs + acc[ai][bj][m][n]; } }
    }
};
struct EpiSwiGLU {
    static constexpr bool PERM = true, AFTER_DRAIN = false;
    bf16_t* O;
    __device__ __forceinline__ void operator()(const f32x4 (&acc)[2][2][4][2], const Unit& u, int wr, int wc, int fr, int fq) const {
        const int row0 = u.pm * BM + wr * 64 + fr; const int col0 = (u.pn & 3) * HALF + wc * 32 + 8 * fq;
#pragma unroll
        for (int ai = 0; ai < 2; ++ai)
#pragma unroll
            for (int m = 0; m < 4; ++m) { bf16_t* rowp = O + (size_t)(row0 + ai * HALF + m * 16) * 512 + col0;
                float o[8];
#pragma unroll
                for (int n = 0; n < 2; ++n)
#pragma unroll
                    for (int i = 0; i < 4; ++i) { const float a = acc[ai][0][m][n][i], b = acc[ai][1][m][n][i]; o[n * 4 + i] = a * __builtin_amdgcn_rcpf(1.0f + __expf(-a)) * b; }
                u32x4 w; w.x = cvt_pk_bf16(o[0], o[1]); w.y = cvt_pk_bf16(o[2], o[3]); w.z = cvt_pk_bf16(o[4], o[5]); w.w = cvt_pk_bf16(o[6], o[7]);
                *(u32x4*)rowp = w; }
    }
};
struct MoeOrder {
    const int* tileE; int nunits, ncol, G, c;
    __device__ __forceinline__ bool next(int i, Unit& u) const {
        const int L = i * G + c; if (L >= nunits) return false;
        const int pm = L / ncol; const int e = __builtin_amdgcn_readfirstlane(tileE[pm]);
        u.pm = pm; u.pn = e * ncol + (L - pm * ncol); return true;
    }
    __device__ __forceinline__ void a_ready(const Unit&) const {}
    __device__ __forceinline__ void done(const Unit&) const {}
};

template <class Epi, class Sched, bool ALIGN_EPI = false, bool SP2 = false>
__device__ __forceinline__ void gemm_phase(PG8_LAS unsigned char* lds, const Gemm g, const Sched& S, const Epi& E) {
    const int tid = threadIdx.x, wid = __builtin_amdgcn_readfirstlane(tid >> 6), lane = tid & 63, wr = wid >> 2, wc = wid & 3, fr = lane & 15, fq = lane >> 4;
    const int K = g.K, nt = K / BK;
    unsigned voffA[2], voffB[2];
#pragma unroll
    for (int i = 0; i < 2; ++i) { int R, C; stage_rc(tid * 16 + i * 8192, R, C); const int Rb = Epi::PERM ? ((R & ~31) + perm32(R & 31)) : R;
        voffA[i] = (unsigned)(R * K + C) * 2u; voffB[i] = (unsigned)(Rb * K + C) * 2u; }
    const size_t kstep = (size_t)(BK * 2);
    const size_t hstep = (size_t)HALF * K * 2;
    const size_t tstep = 2 * hstep;
    const unsigned ldsw = (unsigned)wid * 1024u;
    const int aoff = lds_byte(wr * 64 + fr, fq * 8), boff = lds_byte(wc * 32 + fr, fq * 8);
#define PG8_SA(b, h) (((b) * 2 + (h)) * HTB)
#define PG8_SB(b, h) ((4 + (b) * 2 + (h)) * HTB)
#define PG8_STAGE(bufoff, gbase, voff) do { _Pragma("unroll") for (int _i = 0; _i < 2; ++_i) \
        __builtin_amdgcn_global_load_lds((const unsigned*)((const char*)(gbase) + (voff)[_i]), (PG8_LAS unsigned*)(lds + (bufoff) + ldsw + _i * 8192), 16, 0, 0); } while (0)
#define PG8_LDA(dst, b, h) do { _Pragma("unroll") for (int m = 0; m < 4; ++m) _Pragma("unroll") for (int k = 0; k < 2; ++k) dst[m][k] = *(const PG8_LAS bf16x8*)(lds + PG8_SA(b, h) + aoff + m * 2048 + k * 1024); } while (0)
#define PG8_LDB(dst, b, h) do { _Pragma("unroll") for (int n = 0; n < 2; ++n) _Pragma("unroll") for (int k = 0; k < 2; ++k) dst[n][k] = *(const PG8_LAS bf16x8*)(lds + PG8_SB(b, h) + boff + n * 2048 + k * 1024); } while (0)
#define PG8_MMA(ai, bj, At, Bt) do { __builtin_amdgcn_s_setprio(1); _Pragma("unroll") for (int m = 0; m < 4; ++m) _Pragma("unroll") for (int n = 0; n < 2; ++n) _Pragma("unroll") for (int k = 0; k < 2; ++k) \
        acc[ai][bj][m][n] = __builtin_amdgcn_mfma_f32_16x16x32_bf16(Bt[n][k], At[m][k], acc[ai][bj][m][n], 0, 0, 0); __builtin_amdgcn_s_setprio(0); } while (0)
#define PG8_WAIT_V(n) asm volatile("s_waitcnt vmcnt(" #n ")" ::: "memory")
#define PG8_WAIT_L(n) asm volatile("s_waitcnt lgkmcnt(" #n ")" ::: "memory")
#define PG8_BAR __builtin_amdgcn_s_barrier()
#define PG8_SCHED __builtin_amdgcn_sched_barrier(0)
    Unit cur, nxt; int ui = 0;
    if (!S.next(0, cur)) return;
    f32x4 acc[2][2][4][2];
#pragma unroll
    for (int a = 0; a < 2; ++a)
#pragma unroll
        for (int b = 0; b < 2; ++b)
#pragma unroll
            for (int m = 0; m < 4; ++m)
#pragma unroll
                for (int n = 0; n < 2; ++n) acc[a][b][m][n] = (f32x4){0.f, 0.f, 0.f, 0.f};
    bf16x8 At[4][2], B0[2][2], B1[2][2];
    const char* cA = (const char*)g.A + (size_t)cur.pm * tstep; const char* cB = (const char*)g.Bt + (size_t)cur.pn * tstep;
    S.a_ready(cur);
    if constexpr (SP2) {
        PG8_STAGE(PG8_SB(0, 0), cB, voffB); PG8_STAGE(PG8_SB(0, 1), cB + hstep, voffB); PG8_STAGE(PG8_SA(0, 0), cA, voffA); PG8_STAGE(PG8_SA(0, 1), cA + hstep, voffA);
        if (wr == 1) PG8_BAR;
        PG8_WAIT_V(2); PG8_BAR;
        PG8_STAGE(PG8_SB(1, 0), cB + kstep, voffB); PG8_STAGE(PG8_SA(1, 0), cA + kstep, voffA); PG8_STAGE(PG8_SB(1, 1), cB + hstep + kstep, voffB);
        PG8_WAIT_V(6); PG8_BAR;
    } else {
        PG8_STAGE(PG8_SB(0, 0), cB, voffB); PG8_STAGE(PG8_SA(0, 0), cA, voffA); PG8_STAGE(PG8_SB(0, 1), cB + hstep, voffB); PG8_STAGE(PG8_SA(0, 1), cA + hstep, voffA);
        if (wr == 1) PG8_BAR;
        PG8_WAIT_V(4); PG8_BAR;
        PG8_STAGE(PG8_SB(1, 0), cB + kstep, voffB); PG8_STAGE(PG8_SA(1, 0), cA + kstep, voffA); PG8_STAGE(PG8_SB(1, 1), cB + hstep + kstep, voffB);
        PG8_WAIT_V(6); PG8_BAR;
    }
    for (;;) {
        const bool has_next = S.next(ui + 1, nxt);
        const char* nA = has_next ? (const char*)g.A + (size_t)nxt.pm * tstep : cA; const char* nB = has_next ? (const char*)g.Bt + (size_t)nxt.pn * tstep : cB;
        for (int t = 0; t < nt; t += 2) {
            const bool last = (t == nt - 2);
            const char* a1 = cA + (size_t)(t + 1) * kstep;
            const char* a2 = last ? nA : cA + (size_t)(t + 2) * kstep; const char* b2 = last ? nB : cB + (size_t)(t + 2) * kstep;
            const char* a3 = a2 + kstep; const char* b3 = b2 + kstep;
            if (last && has_next) S.a_ready(nxt);
            if constexpr (SP2) {
            PG8_LDB(B0, 0, 0); PG8_LDB(B1, 0, 1); PG8_SCHED; PG8_LDA(At, 0, 0); PG8_STAGE(PG8_SA(1, 1), a1 + hstep, voffA);
            PG8_WAIT_V(8); PG8_WAIT_L(0); PG8_BAR; PG8_MMA(0, 0, At, B0); PG8_MMA(0, 1, At, B1); PG8_BAR; PG8_SCHED;
            PG8_LDA(At, 0, 1); PG8_STAGE(PG8_SB(0, 0), b2, voffB); PG8_STAGE(PG8_SB(0, 1), b2 + hstep, voffB); PG8_STAGE(PG8_SA(0, 0), a2, voffA);
            PG8_WAIT_V(8); PG8_WAIT_L(0); PG8_BAR; PG8_MMA(1, 0, At, B0); PG8_MMA(1, 1, At, B1); PG8_BAR; PG8_SCHED;
            PG8_LDB(B0, 1, 0); PG8_LDB(B1, 1, 1); PG8_SCHED; PG8_LDA(At, 1, 0); PG8_STAGE(PG8_SA(0, 1), a2 + hstep, voffA);
            PG8_WAIT_V(8); PG8_WAIT_L(0); PG8_BAR; PG8_MMA(0, 0, At, B0); PG8_MMA(0, 1, At, B1); PG8_BAR; PG8_SCHED;
            PG8_LDA(At, 1, 1); PG8_STAGE(PG8_SB(1, 0), b3, voffB); PG8_STAGE(PG8_SB(1, 1), b3 + hstep, voffB); PG8_STAGE(PG8_SA(1, 0), a3, voffA);
            PG8_WAIT_V(8); PG8_WAIT_L(0); PG8_BAR; PG8_MMA(1, 0, At, B0); PG8_MMA(1, 1, At, B1); PG8_BAR; PG8_SCHED;
            } else {
            PG8_LDB(B0, 0, 0); PG8_SCHED; PG8_LDA(At, 0, 0); PG8_STAGE(PG8_SA(1, 1), a1 + hstep, voffA);
            PG8_WAIT_L(8); PG8_BAR; PG8_WAIT_L(0); PG8_MMA(0, 0, At, B0); PG8_BAR; PG8_SCHED;
            PG8_LDB(B1, 0, 1); PG8_STAGE(PG8_SB(0, 0), b2, voffB);
            PG8_BAR; PG8_WAIT_L(0); PG8_MMA(0, 1, At, B1); PG8_BAR;
            PG8_LDA(At, 0, 1); PG8_STAGE(PG8_SA(0, 0), a2, voffA);
            PG8_BAR; PG8_WAIT_L(0); PG8_MMA(1, 0, At, B0); PG8_BAR; PG8_SCHED;
            PG8_STAGE(PG8_SB(0, 1), b2 + hstep, voffB);
            PG8_WAIT_V(6); PG8_BAR; PG8_MMA(1, 1, At, B1); PG8_BAR;
            PG8_LDB(B0, 1, 0); PG8_SCHED; PG8_LDA(At, 1, 0); PG8_STAGE(PG8_SA(0, 1), a2 + hstep, voffA);
            PG8_WAIT_L(8); PG8_BAR; PG8_WAIT_L(0); PG8_MMA(0, 0, At, B0); PG8_BAR; PG8_SCHED;
            PG8_LDB(B1, 1, 1); PG8_STAGE(PG8_SB(1, 0), b3, voffB);
            PG8_BAR; PG8_WAIT_L(0); PG8_MMA(0, 1, At, B1); PG8_BAR;
            PG8_LDA(At, 1, 1); PG8_STAGE(PG8_SA(1, 0), a3, voffA);
            PG8_BAR; PG8_WAIT_L(0); PG8_MMA(1, 0, At, B0); PG8_BAR; PG8_SCHED;
            PG8_STAGE(PG8_SB(1, 1), b3 + hstep, voffB);
            PG8_WAIT_V(6); PG8_BAR; PG8_MMA(1, 1, At, B1); PG8_BAR;
            }
        }
        if constexpr (ALIGN_EPI) { if (wr == 0) PG8_BAR; }
        if constexpr (!Epi::AFTER_DRAIN) { E(acc, cur, wr, wc, fr, fq); S.done(cur); }
        if (!has_next) break;
#pragma unroll
        for (int a = 0; a < 2; ++a)
#pragma unroll
            for (int b = 0; b < 2; ++b)
#pragma unroll
                for (int m = 0; m < 4; ++m)
#pragma unroll
                    for (int n = 0; n < 2; ++n) acc[a][b][m][n] = (f32x4){0.f, 0.f, 0.f, 0.f};
        cur = nxt; cA = nA; cB = nB; ++ui;
        if constexpr (ALIGN_EPI) { if (wr == 1) PG8_BAR; }
    }
    PG8_WAIT_V(0);
    if constexpr (!ALIGN_EPI) { if (wr == 0) PG8_BAR; }
    PG8_BAR;
    if constexpr (Epi::AFTER_DRAIN) { E.fused(acc, cur, wr, wc, fr, fq, lds, wid, lane); S.done(cur); }
#undef PG8_SA
#undef PG8_SB
#undef PG8_STAGE
#undef PG8_LDA
#undef PG8_LDB
#undef PG8_MMA
#undef PG8_WAIT_V
#undef PG8_WAIT_L
#undef PG8_BAR
#undef PG8_SCHED
}
}

constexpr int NWAVES = 8, NTHR = 512;
constexpr int BATCH = 4, SEQ = 4096, DM = 2048, T = BATCH * SEQ;
constexpr int INC = 6400;
constexpr int ZK = 1024, ZV = 2048, ZR = 3072;
constexpr int NE = 64, DE = 512;
constexpr int PMAX = 49152;
constexpr int NPHASE = 10;
constexpr int N_LAUNCHES = MK_N_LAUNCHES;
constexpr float C2 = 0.125f * 1.4426950408889634f;
constexpr float LAM_INIT = 0.2f;

constexpr size_t MiB = 1u << 20;
constexpr size_t WS_CTL = 0, CTL_ZERO_BYTES = 64 * 1024;
constexpr size_t WS_SMALL = 1 * MiB;
constexpr size_t WS_WIN = 9 * MiB;
constexpr size_t WS_WOUT = 34 * MiB;
constexpr size_t WS_W13 = 42 * MiB;
constexpr size_t WS_W2 = 298 * MiB;
constexpr size_t WS_XN = 426 * MiB;
constexpr size_t WS_Z = 490 * MiB;
constexpr size_t WS_STREAM = 690 * MiB;
constexpr size_t WS_HID = 914 * MiB;
constexpr size_t WS_END = 962 * MiB;
constexpr size_t SM_WUP = 0;
constexpr size_t SM_AUP = 128 * 1024;
constexpr size_t SM_GUP = 256 * 1024;
constexpr size_t SM_WRT = 512 * 1024;
constexpr size_t SM_BONUS = 2 * MiB;
constexpr size_t SM_ROUTE_E = 3 * MiB;
constexpr size_t SM_ROUTE_R = 3 * MiB + 128 * 1024;
constexpr size_t SM_ROUTE_G = 3 * MiB + 256 * 1024;
constexpr size_t SM_R2 = 3 * MiB + 384 * 1024;
constexpr size_t SM_SLOT = 3 * MiB + 512 * 1024;
constexpr size_t SM_TILEE = 4 * MiB;
constexpr int CW_QHEAD = 64;
constexpr int CW_NT = 128;
constexpr int CW_BAR = 4096;
constexpr int CW_CNT = 256;

constexpr int RING_BYTES = 131072;
constexpr int MISC_OFF = RING_BYTES;
constexpr int LDS_BYTES = 147456;

#define GAS __attribute__((address_space(1)))
#define LAS __attribute__((address_space(3)))
typedef unsigned short bf16;
typedef unsigned v4u __attribute__((ext_vector_type(4)));
typedef unsigned v2u __attribute__((ext_vector_type(2)));
typedef float f32x4 __attribute__((ext_vector_type(4)));
typedef float f32x16 __attribute__((ext_vector_type(16)));
typedef short bf16x8 __attribute__((ext_vector_type(8)));
typedef short s16x4 __attribute__((ext_vector_type(4)));

__device__ __forceinline__ unsigned f2bf(float f) { unsigned u = __builtin_bit_cast(unsigned, f); return (u + 0x7fffu + ((u >> 16) & 1u)) >> 16; }
__device__ __forceinline__ unsigned pk2(float lo, float hi) { return f2bf(lo) | (f2bf(hi) << 16); }
__device__ __forceinline__ float bf2f(unsigned b) { return __builtin_bit_cast(float, b << 16); }
__device__ __forceinline__ float bflo(unsigned w) { return __builtin_bit_cast(float, w << 16); }
__device__ __forceinline__ float bfhi(unsigned w) { return __builtin_bit_cast(float, w & 0xffff0000u); }
__device__ __forceinline__ float wave_sum(float v) {
#pragma unroll
    for (int o = 1; o < 64; o <<= 1) v += __shfl_xor(v, o);
    return v;
}
template <int CTRL> __device__ __forceinline__ float dpp_mov(float x) { return __builtin_bit_cast(float, __builtin_amdgcn_update_dpp(0, __builtin_bit_cast(int, x), CTRL, 0xF, 0xF, true)); }
__device__ __forceinline__ float reduce16(float x) {
    x += dpp_mov<0xB1>(x);
    x += dpp_mov<0x4E>(x);
    x += dpp_mov<0x141>(x);
    x += dpp_mov<0x140>(x);
    return x;
}
__device__ __forceinline__ float sigmoidf_(float x) { return __builtin_amdgcn_rcpf(1.0f + __expf(-x)); }

#define RLX_AGENT __ATOMIC_RELAXED, __HIP_MEMORY_SCOPE_AGENT
#define XB_TMO      128
#define XB_XCNT(j)  (256  + 64 * (j))
#define XB_XSUB(j)  (1280 + 64 * (j))
#define XB_XGEN(j)  (2304 + 64 * (j))
#define XB_TOP      3328
#define XB_TOPGEN   3392
#define XCD_BAR_WORDS 3456
#define XB_SPIN_CAP (1u << 18)

__device__ __forceinline__ unsigned xb_ld(unsigned* p)              { return __hip_atomic_load(p, __ATOMIC_RELAXED, __HIP_MEMORY_SCOPE_AGENT); }
__device__ __forceinline__ unsigned xb_add(unsigned* p, unsigned v) { return __hip_atomic_fetch_add(p, v, __ATOMIC_RELAXED, __HIP_MEMORY_SCOPE_AGENT); }
__device__ __forceinline__ unsigned xb_xcc_id() { return (unsigned)__builtin_amdgcn_s_getreg((3 << 11) | 20) & 0xFu; }
#define XB_SPIN(cond, bar) do { unsigned _sp = 0; while (cond) { __builtin_amdgcn_s_sleep(1); \
    if ((++_sp & 255u) == 0u) { if (xb_ld(&(bar)[XB_TMO])) break; if (_sp > XB_SPIN_CAP) { atomicAdd(&(bar)[XB_TMO], 1u); break; } } } } while (0)

struct XcdBarrier {
    unsigned* bar; unsigned x;
    volatile LAS unsigned* st;
};

__device__ __forceinline__ XcdBarrier xcd_barrier_post(unsigned* bar, volatile LAS unsigned* st) {
    XcdBarrier b; b.bar = bar; b.x = xb_xcc_id(); b.st = st;
    if (threadIdx.x == 0) (void)xb_add(&bar[XB_XCNT(b.x)], 1u);
    return b;
}
__device__ __forceinline__ void xcd_barrier_complete(unsigned* bar, unsigned x, unsigned& nloc, unsigned& nx) {
    const unsigned G = gridDim.x * gridDim.y * gridDim.z;
    unsigned sum, cnt, mine, sp = 0u;
    for (;;) {
        sum = 0u; cnt = 0u; mine = 0u;
#pragma unroll
        for (unsigned j = 0; j < 16; ++j) { const unsigned c = xb_ld(&bar[XB_XCNT(j)]); sum += c; cnt += (c > 0u) ? 1u : 0u; mine = (j == x) ? c : mine; }
        if (sum == G) break;
        __builtin_amdgcn_s_sleep(1);
        if ((++sp & 255u) == 0u) { if (xb_ld(&bar[XB_TMO])) break; if (sp > XB_SPIN_CAP) { atomicAdd(&bar[XB_TMO], 1u); break; } }
    }
    nloc = mine > 0u ? mine : 1u; nx = cnt > 0u ? cnt : 1u;
}

__device__ __forceinline__ void xcd_barrier(const XcdBarrier& b) {
    asm volatile("s_waitcnt vmcnt(0)" ::: "memory");
    __syncthreads();
    if (threadIdx.x == 0) {
        unsigned* bar = b.bar;
        __builtin_amdgcn_s_waitcnt(0);
        unsigned nloc = b.st[0], nx = b.st[1];
        if (nloc == 0u) { xcd_barrier_complete(bar, b.x, nloc, nx); b.st[0] = nloc; b.st[1] = nx; }
        const unsigned old = xb_add(&bar[XB_XSUB(b.x)], 1u);
        const unsigned gen = old / nloc;
        if (old + 1u == (gen + 1u) * nloc) {
            __builtin_amdgcn_fence(__ATOMIC_RELEASE, "agent");
            asm volatile("s_waitcnt vmcnt(0)" ::: "memory");
            const unsigned og = xb_add(&bar[XB_TOP], 1u);
            const unsigned tg = og / nx;
            if (og + 1u == (tg + 1u) * nx) xb_add(&bar[XB_TOPGEN], 1u);
            else XB_SPIN(xb_ld(&bar[XB_TOPGEN]) == tg, bar);
            __builtin_amdgcn_fence(__ATOMIC_ACQUIRE, "agent");
            xb_add(&bar[XB_XGEN(b.x)], 1u);
            asm volatile("s_waitcnt vmcnt(0)" ::: "memory");
        } else {
            XB_SPIN(xb_ld(&bar[XB_XGEN(b.x)]) == gen, bar);
            __builtin_amdgcn_fence(__ATOMIC_ACQUIRE, "agent");
            asm volatile("s_waitcnt vmcnt(0)" ::: "memory");
        }
    }
    __syncthreads();
}

struct Frame {
    LAS unsigned char* lds;
    volatile LAS unsigned* MISC;
    unsigned* ctl;
    int tid, lane, wave, vcu, G;
    const float *x, *norm1_w, *w_in, *lam_q1, *lam_k1, *lam_q2, *lam_k2, *subln_w, *rw_mu, *rw_w0, *rw_w_up, *rw_a0, *rw_a_up, *rw_g_up, *rw_k_k, *rw_k_a, *rw_r_k, *rw_lnx_w, *rw_lnx_b,
                *w_out, *norm2_w, *rg_w, *rg_b, *re_w, *re_b, *moe_w1, *moe_w3, *moe_w2, *final_w;
    float* out;
    bf16 *WIN, *WOUT, *W13, *W2, *XN, *MIX, *Z, *XG, *STREAM, *Y, *HID, *WUP, *AUP, *GUP;
    float *WRT, *BONUS, *ROUTE_G, *R2;
    int *ROUTE_E, *ROUTE_R, *SLOT, *TILEE;
};

__device__ __forceinline__ void p0_transpose_item(const float* W, int N, bf16* WT, int ldt, int dst_row0, int k0, int n0, const float* kscale, LAS float* scr, int lane) {
#pragma unroll 8
    for (int i = 0; i < 32; ++i) { const int kk = 2 * i + (lane >> 5); float v = W[(size_t)(k0 + kk) * N + n0 + (lane & 31)]; if (kscale) v *= kscale[k0 + kk]; scr[kk * 33 + (lane & 31)] = v; }
    asm volatile("s_waitcnt lgkmcnt(0)" ::: "memory");
    const int c = lane & 7;
#pragma unroll
    for (int j = 0; j < 4; ++j) { const int n = (lane >> 3) + 8 * j; const LAS float* s = scr + (8 * c) * 33 + n;
        v4u o; o.x = pk2(s[0 * 33], s[1 * 33]); o.y = pk2(s[2 * 33], s[3 * 33]); o.z = pk2(s[4 * 33], s[5 * 33]); o.w = pk2(s[6 * 33], s[7 * 33]);
        *(v4u*)(WT + (size_t)(dst_row0 + n) * ldt + k0 + 8 * c) = o; }
    asm volatile("s_waitcnt lgkmcnt(0)" ::: "memory");
}
__device__ __forceinline__ void p0_prologue(const Frame& F) {
    LAS float* scr = (LAS float*)(F.lds + F.wave * 16384);
    const int gw = F.vcu * NWAVES + F.wave, NGW = F.G * NWAVES, lane = F.lane;
    constexpr int I_IN = 32 * 200, I_OUT = 32 * 64, I_W1 = 64 * 32 * 16, I_W2 = 64 * 8 * 64, I_UP = 32, I_GUP = 64;
    constexpr int NITEMS = I_IN + I_OUT + 2 * I_W1 + I_W2 + 2 * I_UP + I_GUP;
    for (int it = gw; it < NITEMS; it += NGW) {
        int r = it;
        if (r < I_IN) { const int kb = r / 200, nb = r % 200; p0_transpose_item(F.w_in, INC, F.WIN, DM, 32 * nb, 64 * kb, 32 * nb, F.norm1_w, scr, lane); continue; } r -= I_IN;
        if (r < I_OUT) { const int kb = r / 64, nb = r % 64; p0_transpose_item(F.w_out, DM, F.WOUT, DM, 32 * nb, 64 * kb, 32 * nb, nullptr, scr, lane); continue; } r -= I_OUT;
        if (r < 2 * I_W1) { const int which = r / I_W1; r -= which * I_W1; const int e = r / 512, q = r % 512, kb = q / 16, nb = q % 16, n0 = 32 * nb;
            const float* W = (which ? F.moe_w3 : F.moe_w1) + (size_t)e * DM * DE;
            p0_transpose_item(W, DE, F.W13, DM, e * 1024 + (n0 >> 7) * 256 + which * 128 + (n0 & 127), 64 * kb, n0, nullptr, scr, lane); continue; } r -= 2 * I_W1;
        if (r < I_W2) { const int e = r / 512, q = r % 512, kb = q / 64, nb = q % 64;
            p0_transpose_item(F.moe_w2 + (size_t)e * DE * DM, DM, F.W2, DE, e * 2048 + 32 * nb, 64 * kb, 32 * nb, nullptr, scr, lane); continue; } r -= I_W2;
        if (r < I_UP) { p0_transpose_item(F.rw_w_up, 1024, F.WUP, 64, 32 * r, 0, 32 * r, nullptr, scr, lane); continue; } r -= I_UP;
        if (r < I_UP) { p0_transpose_item(F.rw_a_up, 1024, F.AUP, 64, 32 * r, 0, 32 * r, nullptr, scr, lane); continue; } r -= I_UP;
        { const int kb = r / 32, nb = r % 32; p0_transpose_item(F.rw_g_up, 1024, F.GUP, 128, 32 * nb, 64 * kb, 32 * nb, nullptr, scr, lane); }
    }
    for (int i = (F.vcu * NTHR + F.tid); i < 80 * DM; i += F.G * NTHR) { const int n = i / DM, k = i % DM;
        float v = 0.f; if (n < 8) v = F.rg_w[k * 8 + n]; else if (n < 72) v = F.re_w[k * 64 + (n - 8)];
        F.WRT[i] = v * F.norm2_w[k]; }
    for (int m = gw; m < T; m += NGW) {
        const f32x4* xr = (const f32x4*)(F.x + (size_t)m * DM) + lane;
        f32x4 v[8]; float s = 0.f;
#pragma unroll
        for (int j = 0; j < 8; ++j) { v[j] = xr[64 * j]; s += (v[j].x * v[j].x + v[j].y * v[j].y) + (v[j].z * v[j].z + v[j].w * v[j].w); }
        const float rs = 1.0f / sqrtf(wave_sum(s) * (1.0f / DM) + 1e-6f);
        unsigned long long* o8 = (unsigned long long*)(F.XN + (size_t)m * DM) + lane;
#pragma unroll
        for (int j = 0; j < 8; ++j) o8[64 * j] = (unsigned long long)pk2(v[j].x * rs, v[j].y * rs) | ((unsigned long long)pk2(v[j].z * rs, v[j].w * rs) << 32);
    }
}


constexpr int ST_TOK = 7 * 64;
constexpr int AT_PITCH = 264;
__device__ __forceinline__ void prep_unit(const Frame& F, int unit, bool do_rope) {
    const int tid = F.tid, lane = F.lane, wave = F.wave;
    const int row0 = unit * 16, tpos0 = row0 & (SEQ - 1), bidx = row0 >> 12;
    bf16* Z = F.Z;
    if (do_rope) {
        const int tk = tid >> 5, i = tid & 31;
        const float pos = (float)(tpos0 + tk);
        const float inv = exp2f(-(float)i * (13.287712379549449f / 32.0f));
        const float ang = pos * inv;
        const float sn = sinf(ang), cs = cosf(ang);
        bf16* zr = Z + (size_t)(row0 + tk) * INC;
#pragma unroll 4
        for (int hh = 0; hh < 32; ++hh) {
            const int col = hh * 64 + i;
            const float x1 = bf2f(zr[col]), x2 = bf2f(zr[col + 32]);
            float o1 = x1 * cs - x2 * sn, o2 = x2 * cs + x1 * sn;
            if (hh < 16) { o1 *= C2; o2 *= C2; }
            zr[col] = (bf16)f2bf(o1); zr[col + 32] = (bf16)f2bf(o2);
        }
    }
    LAS bf16* At = (LAS bf16*)F.lds;
    {
        const int tk = tid >> 5, c8 = (tid & 31) * 8;
        const bool first = (tpos0 + tk) == 0;
        const bf16* zc = Z + (size_t)(row0 + tk) * INC + ZR + 3072 + c8;
        const v4u cur = *(const v4u*)zc;
        v4u prv = (v4u){0u, 0u, 0u, 0u}; if (!first) prv = *(const v4u*)(zc - INC);
        const f32x4 mu0 = *(const f32x4*)(F.rw_mu + 3072 + c8), mu1 = *(const f32x4*)(F.rw_mu + 3072 + c8 + 4);
        float v[8];
#pragma unroll
        for (int j = 0; j < 4; ++j) { const float c0 = bflo(cur[j]), c1 = bfhi(cur[j]), p0 = bflo(prv[j]), p1 = bfhi(prv[j]);
            const float m0 = (j < 2) ? mu0[2 * j] : mu1[2 * j - 4], m1 = (j < 2) ? mu0[2 * j + 1] : mu1[2 * j - 3];
            v[2 * j] = c0 + (p0 - c0) * m0; v[2 * j + 1] = c1 + (p1 - c1) * m1; }
        if (c8 < 64) {
#pragma unroll
            for (int j = 0; j < 8; ++j) { const float e = __expf(2.0f * v[j]); v[j] = 1.0f - 2.0f * __builtin_amdgcn_rcpf(e + 1.0f); }
        } else if (c8 >= 128) {
#pragma unroll
            for (int j = 0; j < 8; ++j) v[j] = sigmoidf_(v[j]);
        }
        v4u o; o.x = pk2(v[0], v[1]); o.y = pk2(v[2], v[3]); o.z = pk2(v[4], v[5]); o.w = pk2(v[6], v[7]);
        *(LAS v4u*)(At + tk * AT_PITCH + c8) = o;
    }
    __syncthreads();
    const int l15 = lane & 15, l4 = lane >> 4;
    bf16x8 aW[2], aA[2], aG[4];
#pragma unroll
    for (int ks = 0; ks < 2; ++ks) { aW[ks] = *(const LAS bf16x8*)(At + l15 * AT_PITCH + ks * 32 + 8 * l4); aA[ks] = *(const LAS bf16x8*)(At + l15 * AT_PITCH + 64 + ks * 32 + 8 * l4); }
#pragma unroll
    for (int ks = 0; ks < 4; ++ks) aG[ks] = *(const LAS bf16x8*)(At + l15 * AT_PITCH + 128 + ks * 32 + 8 * l4);
    for (int hh = 0; hh < 2; ++hh) {
        const int h = wave * 2 + hh;
        float kkr[4][4], apv[4][4], ssq[4] = {0.f, 0.f, 0.f, 0.f}, bon[4] = {0.f, 0.f, 0.f, 0.f};
        bf16* sbase = F.STREAM + ((size_t)(bidx * 16 + h) * SEQ + tpos0) * ST_TOK;
#pragma unroll
        for (int nt = 0; nt < 4; ++nt) {
            const int c = h * 64 + nt * 16 + l15;
            f32x4 accW = (f32x4){0.f, 0.f, 0.f, 0.f}, accA = accW, accG = accW;
#pragma unroll
            for (int ks = 0; ks < 2; ++ks) {
                const bf16x8 bW = *(const bf16x8*)(F.WUP + (size_t)c * 64 + ks * 32 + 8 * l4);
                const bf16x8 bA = *(const bf16x8*)(F.AUP + (size_t)c * 64 + ks * 32 + 8 * l4);
                accW = __builtin_amdgcn_mfma_f32_16x16x32_bf16(aW[ks], bW, accW, 0, 0, 0);
                accA = __builtin_amdgcn_mfma_f32_16x16x32_bf16(aA[ks], bA, accA, 0, 0, 0);
            }
#pragma unroll
            for (int ks = 0; ks < 4; ++ks) {
                const bf16x8 bG = *(const bf16x8*)(F.GUP + (size_t)c * 128 + ks * 32 + 8 * l4);
                accG = __builtin_amdgcn_mfma_f32_16x16x32_bf16(aG[ks], bG, accG, 0, 0, 0);
            }
            const float mur = F.rw_mu[c], muk = F.rw_mu[1024 + c], muv = F.rw_mu[2048 + c];
            const float w0 = F.rw_w0[c], a0 = F.rw_a0[c], k_k = F.rw_k_k[c], k_a = F.rw_k_a[c], r_k = F.rw_r_k[c];
#pragma unroll
            for (int r = 0; r < 4; ++r) {
                const int tk = 4 * l4 + r;
                const bf16* zc = Z + (size_t)(row0 + tk) * INC + ZR + c;
                const bool first = (tpos0 + tk) == 0;
                float rc = bf2f(zc[0]), kc = bf2f(zc[1024]), vc = bf2f(zc[2048]);
                float rp = 0.f, kp = 0.f, vp = 0.f;
                if (!first) { rp = bf2f(zc[-INC]); kp = bf2f(zc[1024 - INC]); vp = bf2f(zc[2048 - INC]); }
                const float rv = rc + (rp - rc) * mur, kv = kc + (kp - kc) * muk, vv = vc + (vp - vc) * muv;
                const float sg = sigmoidf_(accW[r] + w0);
                const float xw = 1.0f - __expf(-0.6065306597126334f * sg);
                const float ap = sigmoidf_(accA[r] + a0);
                const float kr = kv * k_k;
                ssq[r] += kr * kr; kkr[nt][r] = kr; apv[nt][r] = ap;
                const float kprime = kv * (1.0f + (ap - 1.0f) * k_a);
                bon[r] += rv * kprime * r_k;
                bf16* sp = sbase + (size_t)tk * ST_TOK + nt * 16 + l15;
                sp[0 * 64] = (bf16)f2bf(rv); sp[1 * 64] = (bf16)f2bf(kprime); sp[2 * 64] = (bf16)f2bf(vv); sp[5 * 64] = (bf16)f2bf(xw); sp[6 * 64] = (bf16)f2bf(accG[r]);
            }
        }
#pragma unroll
        for (int r = 0; r < 4; ++r) { ssq[r] = reduce16(ssq[r]); bon[r] = reduce16(bon[r]); }
#pragma unroll
        for (int r = 0; r < 4; ++r) {
            const int tk = 4 * l4 + r;
            const float inv = 1.0f / fmaxf(sqrtf(ssq[r]), 1e-12f);
#pragma unroll
            for (int nt = 0; nt < 4; ++nt) { const float kk = kkr[nt][r] * inv; bf16* sp = sbase + (size_t)tk * ST_TOK + nt * 16 + l15;
                sp[3 * 64] = (bf16)f2bf(-kk); sp[4 * 64] = (bf16)f2bf(kk * apv[nt][r]); }
            if (l15 == 0) F.BONUS[(size_t)(bidx * 16 + h) * SEQ + tpos0 + tk] = bon[r];
        }
    }
    __syncthreads();
}


namespace att {
constexpr int L_K = 0, L_V = 16384, L_WS = 32768, L_XB = 36864;
typedef short v4i16_t __attribute__((ext_vector_type(4)));
__device__ __forceinline__ int crow(int r, int hi) { return (r & 3) + 8 * (r >> 2) + 4 * hi; }
__device__ __forceinline__ unsigned cvtpk(float lo, float hi) { typedef float f2 __attribute__((ext_vector_type(2))); typedef __bf16 b2 __attribute__((ext_vector_type(2)));
    f2 v = {lo, hi}; b2 b = __builtin_convertvector(v, b2); return __builtin_bit_cast(unsigned, b); }
__device__ __forceinline__ s16x4 vtr(const LAS char* p) { return __builtin_bit_cast(s16x4, __builtin_amdgcn_ds_read_tr16_b64_v4i16((LAS v4i16_t*)p)); }

__device__ __forceinline__ void attn_item(const Frame& F, int b, int hv, int qb, float lam) {
    const int tid = F.tid, lane = F.lane, wid = F.wave, r32 = lane & 31, hi = lane >> 5;
    const int hsel = wid >> 2, wq = wid & 3, hq = 2 * hv + hsel;
    const int q0 = qb * 128 + wq * 32;
    const bf16* Zb = F.Z + (size_t)b * SEQ * INC;
    LAS char* shm = (LAS char*)F.lds;
    LAS float* wsf = (LAS float*)(shm + L_WS) + wid * 64;
    bf16x8 qr[4];
#pragma unroll
    for (int d0 = 0; d0 < 4; ++d0) qr[d0] = *(const bf16x8*)(Zb + (size_t)(q0 + r32) * INC + hq * 64 + d0 * 16 + hi * 8);
    const int NT = 2 * qb + 2;
    const bf16* ksrc = Zb + (size_t)lane * INC + ZK + hv * 128 + wid * 16;
    const bf16* vsrc0 = Zb + (size_t)(16 * ((2 * wid) & 3) + (lane >> 2)) * INC + ZV + hv * 128 + ((2 * wid) >> 2) * 32 + (lane & 3) * 8;
    const bf16* vsrc1 = Zb + (size_t)(16 * ((2 * wid + 1) & 3) + (lane >> 2)) * INC + ZV + hv * 128 + ((2 * wid + 1) >> 2) * 32 + (lane & 3) * 8;
    LAS char* kdst = shm + L_K + (2 * wid) * 1024 + lane * 16;
    LAS char* vdst = shm + L_V + (2 * wid) * 1024 + lane * 16;
    v4u kreg0, kreg1, vreg0, vreg1;
    kreg0 = *(const v4u*)(ksrc); kreg1 = *(const v4u*)(ksrc + 8); vreg0 = *(const v4u*)vsrc0; vreg1 = *(const v4u*)vsrc1;
    float m = -1e30f, l = 0.f;
    f32x16 o[4];
#pragma unroll
    for (int d = 0; d < 4; ++d) o[d] = (f32x16){};
    const LAS char* kp = shm + L_K + hsel * 8192 + hi * 1024 + r32 * 16;
    const LAS char* vp = shm + L_V + ((lane >> 4) & 1) * 32 + (lane & 3) * 8 + (4 * hi + ((lane & 15) >> 2)) * 64;
    for (int t = 0; t < NT; ++t) {
        __syncthreads();
        *(LAS v4u*)(kdst) = kreg0; *(LAS v4u*)(kdst + 1024) = kreg1; *(LAS v4u*)(vdst) = vreg0; *(LAS v4u*)(vdst + 1024) = vreg1;
        if (t + 1 < NT) { const size_t adv = (size_t)(t + 1) * 64 * INC;
            kreg0 = *(const v4u*)(ksrc + adv); kreg1 = *(const v4u*)(ksrc + adv + 8); vreg0 = *(const v4u*)(vsrc0 + adv); vreg1 = *(const v4u*)(vsrc1 + adv); }
        __syncthreads();
        if (t * 64 <= q0 + 31) {
            f32x16 p0 = (f32x16){}, p1 = (f32x16){};
#pragma unroll
            for (int d0 = 0; d0 < 4; ++d0) {
                const bf16x8 k0 = *(const LAS bf16x8*)(kp + d0 * 2048), k1 = *(const LAS bf16x8*)(kp + d0 * 2048 + 512);
                p0 = __builtin_amdgcn_mfma_f32_32x32x16_bf16(k0, qr[d0], p0, 0, 0, 0);
                p1 = __builtin_amdgcn_mfma_f32_32x32x16_bf16(k1, qr[d0], p1, 0, 0, 0);
            }
            if (t >= NT - 2) {
                const int qpos = q0 + r32, kb = t * 64 + 4 * hi;
#pragma unroll
                for (int r = 0; r < 16; ++r) { const int kv = kb + (r & 3) + 8 * (r >> 2); if (kv > qpos) p0[r] = -1e30f; if (kv + 32 > qpos) p1[r] = -1e30f; }
            }
            float mx = fmaxf(p0[0], p1[0]);
#pragma unroll
            for (int r = 1; r < 16; ++r) mx = fmaxf(mx, fmaxf(p0[r], p1[r]));
            { auto rr = __builtin_amdgcn_permlane32_swap(__builtin_bit_cast(unsigned, mx), __builtin_bit_cast(unsigned, mx), false, false);
              mx = fmaxf(__builtin_bit_cast(float, rr[0]), __builtin_bit_cast(float, rr[1])); }
            const float mn = fmaxf(m, mx), f = __builtin_amdgcn_exp2f(m - mn); m = mn;
            float ps = 0.f;
#pragma unroll
            for (int r = 0; r < 16; ++r) { p0[r] = __builtin_amdgcn_exp2f(p0[r] - mn); p1[r] = __builtin_amdgcn_exp2f(p1[r] - mn); ps += p0[r] + p1[r]; }
            l = l * f + ps;
            if (hi == 0) wsf[r32] = f;
            v4u pw0, pw1, pw2, pw3;
            pw0.x = cvtpk(p0[0], p0[1]); pw0.y = cvtpk(p0[2], p0[3]); pw0.z = cvtpk(p0[4], p0[5]); pw0.w = cvtpk(p0[6], p0[7]);
            pw1.x = cvtpk(p0[8], p0[9]); pw1.y = cvtpk(p0[10], p0[11]); pw1.z = cvtpk(p0[12], p0[13]); pw1.w = cvtpk(p0[14], p0[15]);
            pw2.x = cvtpk(p1[0], p1[1]); pw2.y = cvtpk(p1[2], p1[3]); pw2.z = cvtpk(p1[4], p1[5]); pw2.w = cvtpk(p1[6], p1[7]);
            pw3.x = cvtpk(p1[8], p1[9]); pw3.y = cvtpk(p1[10], p1[11]); pw3.z = cvtpk(p1[12], p1[13]); pw3.w = cvtpk(p1[14], p1[15]);
            {
                float fr[16];
#pragma unroll
                for (int r = 0; r < 16; ++r) fr[r] = wsf[crow(r, hi)];
#pragma unroll
                for (int d = 0; d < 4; ++d)
#pragma unroll
                    for (int r = 0; r < 16; ++r) o[d][r] *= fr[r];
            }
#pragma unroll
            for (int d = 0; d < 4; ++d) {
                s16x4 lo[4], hh[4];
#pragma unroll
                for (int ks = 0; ks < 4; ++ks) { lo[ks] = vtr(vp + d * 4096 + ks * 1024); hh[ks] = vtr(vp + d * 4096 + ks * 1024 + 512); }
#define ATT_VF(k) (bf16x8){lo[k][0], lo[k][1], lo[k][2], lo[k][3], hh[k][0], hh[k][1], hh[k][2], hh[k][3]}
                o[d] = __builtin_amdgcn_mfma_f32_32x32x16_bf16(__builtin_bit_cast(bf16x8, pw0), ATT_VF(0), o[d], 0, 0, 0);
                o[d] = __builtin_amdgcn_mfma_f32_32x32x16_bf16(__builtin_bit_cast(bf16x8, pw1), ATT_VF(1), o[d], 0, 0, 0);
                o[d] = __builtin_amdgcn_mfma_f32_32x32x16_bf16(__builtin_bit_cast(bf16x8, pw2), ATT_VF(2), o[d], 0, 0, 0);
                o[d] = __builtin_amdgcn_mfma_f32_32x32x16_bf16(__builtin_bit_cast(bf16x8, pw3), ATT_VF(3), o[d], 0, 0, 0);
#undef ATT_VF
            }
        }
    }
    { auto rr = __builtin_amdgcn_permlane32_swap(__builtin_bit_cast(unsigned, l), __builtin_bit_cast(unsigned, l), false, false);
      l = __builtin_bit_cast(float, rr[0]) + __builtin_bit_cast(float, rr[1]); }
    if (hi == 0) wsf[32 + r32] = (hsel ? lam : 1.0f) / l;
    {
        float rl[16];
#pragma unroll
        for (int r = 0; r < 16; ++r) rl[r] = wsf[32 + crow(r, hi)];
#pragma unroll
        for (int d = 0; d < 4; ++d)
#pragma unroll
            for (int r = 0; r < 16; ++r) o[d][r] *= rl[r];
    }
    LAS float* xb = (LAS float*)(shm + L_XB) + wq * 4096 + lane;
    if (hsel) {
#pragma unroll
        for (int d = 0; d < 4; ++d)
#pragma unroll
            for (int r = 0; r < 16; ++r) xb[(d * 16 + r) * 64] = o[d][r];
    }
    __syncthreads();
    if (!hsel) {
        float ss[16];
#pragma unroll
        for (int r = 0; r < 16; ++r) ss[r] = 0.f;
#pragma unroll
        for (int d = 0; d < 4; ++d)
#pragma unroll
            for (int r = 0; r < 16; ++r) { o[d][r] -= xb[(d * 16 + r) * 64]; ss[r] += o[d][r] * o[d][r]; }
        float sw[4];
#pragma unroll
        for (int d = 0; d < 4; ++d) sw[d] = F.subln_w[d * 32 + r32] * (1.0f - LAM_INIT);
#pragma unroll
        for (int r = 0; r < 16; ++r) {
            float s = reduce16(ss[r]); s += __shfl_xor(s, 16);
            const float rs = 1.0f / sqrtf(s * (1.0f / 128.0f) + 1e-5f);
            bf16* orow = F.MIX + (size_t)(b * SEQ + q0 + crow(r, hi)) * DM + hv * 128 + r32;
#pragma unroll
            for (int d = 0; d < 4; ++d) orow[d * 32] = (bf16)f2bf(o[d][r] * rs * sw[d]);
        }
    }
}
}


namespace scan {
constexpr int L_CB = 0, L_GB = 49152, L_YB = 57344, CH = 32;
__device__ __forceinline__ void scan_item(const Frame& F, int bh) {
    const int tid = F.tid, p = tid >> 4, q = tid & 15;
    const int b = bh >> 4, h = bh & 15;
    LAS float* CB = (LAS float*)(F.lds + L_CB); LAS float* GB = (LAS float*)(F.lds + L_GB); LAS float* YB = (LAS float*)(F.lds + L_YB);
    const bf16* sbase = F.STREAM + (size_t)bh * SEQ * ST_TOK;
    const float* bonus = F.BONUS + (size_t)bh * SEQ;
    float s0[4] = {0.f, 0.f, 0.f, 0.f}, s1[4] = {0.f, 0.f, 0.f, 0.f};
    v4u pf[4];
#pragma unroll
    for (int i = 0; i < 4; ++i) { const int pid = tid + 512 * i; if (pid < 1792) pf[i] = *(const v4u*)(sbase + (size_t)pid * 8); }
    const f32x4 lw = *(const f32x4*)(F.rw_lnx_w + h * 64 + 4 * q), lb = *(const f32x4*)(F.rw_lnx_b + h * 64 + 4 * q);
    for (int c = 0; c < SEQ / CH; ++c) {
        __syncthreads();
#pragma unroll
        for (int i = 0; i < 4; ++i) { const int pid = tid + 512 * i;
            if (pid < 1792) { const int tok = pid / 56, rem = pid - tok * 56, arr = rem >> 3, j8 = (rem & 7) * 8;
                float v[8];
#pragma unroll
                for (int j = 0; j < 4; ++j) { v[2 * j] = bflo(pf[i][j]); v[2 * j + 1] = bfhi(pf[i][j]); }
                if (arr == 5) {
#pragma unroll
                    for (int j = 0; j < 8; ++j) v[j] = 1.0f - v[j];
                }
                LAS float* dst = (arr < 6) ? (CB + tok * 384 + arr * 64 + j8) : (GB + tok * 64 + j8);
                *(LAS f32x4*)dst = (f32x4){v[0], v[1], v[2], v[3]}; *(LAS f32x4*)(dst + 4) = (f32x4){v[4], v[5], v[6], v[7]}; } }
        if (c + 1 < SEQ / CH) {
#pragma unroll
            for (int i = 0; i < 4; ++i) { const int pid = tid + 512 * i; if (pid < 1792) pf[i] = *(const v4u*)(sbase + (size_t)(c + 1) * CH * ST_TOK + (size_t)pid * 8); }
        }
        const float bon = bonus[c * CH + p];
        __syncthreads();
#pragma unroll 4
        for (int tt = 0; tt < CH; ++tt) {
            const LAS float* cb = CB + tt * 384;
            const f32x4 r4 = *(const LAS f32x4*)(cb + 4 * q), k4 = *(const LAS f32x4*)(cb + 64 + 4 * q), a4 = *(const LAS f32x4*)(cb + 192 + 4 * q),
                        b4 = *(const LAS f32x4*)(cb + 256 + 4 * q), w4 = *(const LAS f32x4*)(cb + 320 + 4 * q);
            const float v0 = cb[128 + 2 * p], v1 = cb[128 + 2 * p + 1];
            float sa0 = (s0[0] * a4[0] + s0[1] * a4[1]) + (s0[2] * a4[2] + s0[3] * a4[3]);
            float sa1 = (s1[0] * a4[0] + s1[1] * a4[1]) + (s1[2] * a4[2] + s1[3] * a4[3]);
            sa0 = reduce16(sa0); sa1 = reduce16(sa1);
#pragma unroll
            for (int j = 0; j < 4; ++j) { s0[j] = fmaf(sa0, b4[j], fmaf(s0[j], w4[j], v0 * k4[j])); s1[j] = fmaf(sa1, b4[j], fmaf(s1[j], w4[j], v1 * k4[j])); }
            float y0 = (s0[0] * r4[0] + s0[1] * r4[1]) + (s0[2] * r4[2] + s0[3] * r4[3]);
            float y1 = (s1[0] * r4[0] + s1[1] * r4[1]) + (s1[2] * r4[2] + s1[3] * r4[3]);
            y0 = reduce16(y0); y1 = reduce16(y1);
            if (q == 0) { YB[tt * 64 + 2 * p] = y0; YB[tt * 64 + 2 * p + 1] = y1; }
        }
        __syncthreads();
        {
            const f32x4 y4 = *(const LAS f32x4*)(YB + p * 64 + 4 * q);
            const float mean = reduce16((y4[0] + y4[1]) + (y4[2] + y4[3])) * (1.0f / 64.0f);
            const f32x4 d4 = y4 - mean;
            const float var = reduce16((d4[0] * d4[0] + d4[1] * d4[1]) + (d4[2] * d4[2] + d4[3] * d4[3])) * (1.0f / 64.0f);
            const float rs = 1.0f / sqrtf(var + 64e-5f);
            const f32x4 v4 = *(const LAS f32x4*)(CB + p * 384 + 128 + 4 * q), g4 = *(const LAS f32x4*)(GB + p * 64 + 4 * q);
            f32x4 o = (d4 * rs * lw + lb + v4 * bon) * g4;
            v2u w; w.x = pk2(o[0], o[1]); w.y = pk2(o[2], o[3]);
            *(v2u*)(F.MIX + (size_t)(b * SEQ + c * CH + p) * DM + 1024 + h * 64 + 4 * q) = w;
        }
    }
}
}

__device__ __forceinline__ void p3_mix(const Frame& F, int qword) {
    float lam;
    { float d1 = 0.f, d2 = 0.f;
      for (int i = 0; i < 64; ++i) { d1 += F.lam_q1[i] * F.lam_k1[i]; d2 += F.lam_q2[i] * F.lam_k2[i]; }
      lam = __expf(d1) - __expf(d2) + LAM_INIT; }
    for (;;) {
        if (F.tid == 0) F.MISC[0] = atomicAdd(F.ctl + qword, 1u);
        __syncthreads();
        const int id = (int)__builtin_amdgcn_readfirstlane(F.MISC[0]);
        __syncthreads();
        if (id >= 64 + 1024) break;
        if (id < 64) scan::scan_item(F, id);
        else { const int a = id - 64; const int qb = 31 - (a >> 5), bhv = a & 31; att::attn_item(F, bhv >> 3, bhv & 7, qb, lam); }
    }
}


__device__ __forceinline__ void router_tile(const Frame& F, int tile, int cntw) {
    const int lane = F.lane, wid = F.wave, blk = wid & 3, kh = wid >> 2, l15 = lane & 15, l4 = lane >> 4;
    LAS float* xb = (LAS float*)F.lds;
    LAS float* lg = (LAS float*)(F.lds + 32768);
    const float* hrow = F.out + (size_t)(tile * 64 + blk * 16 + l15) * DM + kh * 1024 + 4 * l4;
    const float* wrow = F.WRT + (size_t)l15 * DM + kh * 1024 + 4 * l4;
    f32x4 acc[5];
#pragma unroll
    for (int nb = 0; nb < 5; ++nb) acc[nb] = (f32x4){0.f, 0.f, 0.f, 0.f};
    float ssq = 0.f;
#pragma unroll 2
    for (int s = 0; s < 64; ++s) {
        const f32x4 a = *(const f32x4*)(hrow + s * 16);
        f32x4 bq[5];
#pragma unroll
        for (int nb = 0; nb < 5; ++nb) bq[nb] = *(const f32x4*)(wrow + (size_t)nb * 16 * DM + s * 16);
        ssq += (a[0] * a[0] + a[1] * a[1]) + (a[2] * a[2] + a[3] * a[3]);
#pragma unroll
        for (int e = 0; e < 4; ++e)
#pragma unroll
            for (int nb = 0; nb < 5; ++nb) acc[nb] = __builtin_amdgcn_mfma_f32_16x16x4f32(a[e], bq[nb][e], acc[nb], 0, 0, 0);
    }
    ssq += __shfl_xor(ssq, 16); ssq += __shfl_xor(ssq, 32);
    __syncthreads();
    if (kh == 1) {
#pragma unroll
        for (int nb = 0; nb < 5; ++nb)
#pragma unroll
            for (int r = 0; r < 4; ++r) xb[(blk * 21 + nb * 4 + r) * 64 + lane] = acc[nb][r];
        xb[(blk * 21 + 20) * 64 + lane] = ssq;
    }
    __syncthreads();
    if (kh == 0) {
#pragma unroll
        for (int nb = 0; nb < 5; ++nb)
#pragma unroll
            for (int r = 0; r < 4; ++r) lg[(blk * 16 + 4 * l4 + r) * 81 + nb * 16 + l15] = acc[nb][r] + xb[(blk * 21 + nb * 4 + r) * 64 + lane];
        if (l4 == 0) lg[(blk * 16 + l15) * 81 + 80] = ssq + xb[(blk * 21 + 20) * 64 + lane];
    }
    __syncthreads();
    if (kh == 0 && lane < 16) {
        const int t = tile * 64 + blk * 16 + lane;
        const LAS float* L = lg + (blk * 16 + lane) * 81;
        const float r2 = 1.0f / sqrtf(L[80] * (1.0f / DM) + 1e-6f);
        float gl[8]; float gm = -3.0e38f; int gs = 0;
#pragma unroll
        for (int i = 0; i < 8; ++i) { gl[i] = L[i] * r2 + F.rg_b[i]; if (gl[i] > gm) { gm = gl[i]; gs = i; } }
        float gsum = 0.f;
#pragma unroll
        for (int i = 0; i < 8; ++i) gsum += __expf(gl[i] - gm);
        const float pg = 1.0f / gsum;
        float el[8]; float m0 = -3.0e38f, m1 = -3.0e38f; int i0 = 0, i1 = 0;
        #pragma unroll
        for (int i = 0; i < 8; ++i) { el[i] = L[8 + gs * 8 + i] * r2 + F.re_b[gs * 8 + i]; }
#pragma unroll
        for (int i = 0; i < 8; ++i) { if (el[i] > m0) { m1 = m0; i1 = i0; m0 = el[i]; i0 = i; } else if (el[i] > m1) { m1 = el[i]; i1 = i; } }
        const float e1 = __expf(m1 - m0);
        const float g0 = pg / (1.0f + e1), g1 = pg * e1 / (1.0f + e1);
        const int x0 = gs * 8 + i0, x1 = gs * 8 + i1;
        const int rk0 = (int)atomicAdd(F.ctl + cntw + x0, 1u), rk1 = (int)atomicAdd(F.ctl + cntw + x1, 1u);
        F.ROUTE_E[2 * t] = x0; F.ROUTE_E[2 * t + 1] = x1; F.ROUTE_R[2 * t] = rk0; F.ROUTE_R[2 * t + 1] = rk1;
        F.ROUTE_G[2 * t] = g0; F.ROUTE_G[2 * t + 1] = g1; F.R2[t] = r2;
    }
}
__device__ __forceinline__ void p6_gather(const Frame& F) {
    LAS int* tb = (LAS int*)F.lds;
    __syncthreads();
    if (F.tid == 0) { int acc = 0; for (int e = 0; e < NE; ++e) { tb[e] = acc; const int cnt = (int)__hip_atomic_load(F.ctl + CW_CNT + e, __ATOMIC_RELAXED, __HIP_MEMORY_SCOPE_AGENT); acc += (cnt + 255) >> 8; } tb[NE] = acc; }
    __syncthreads();
    if (blockIdx.x == 0) {
        if (F.tid < NE) { const int lo = tb[F.tid], hi = tb[F.tid + 1]; for (int i = lo; i < hi; ++i) F.TILEE[i] = F.tid; }
        if (F.tid == 0) F.ctl[CW_NT] = (unsigned)tb[NE];
    }
    const int gw = F.vcu * NWAVES + F.wave, NGW = F.G * NWAVES, lane = F.lane;
    f32x4 nw[8];
#pragma unroll
    for (int j = 0; j < 8; ++j) nw[j] = ((const f32x4*)F.norm2_w)[64 * j + lane];
    for (int t = gw; t < T; t += NGW) {
        const int e0 = F.ROUTE_E[2 * t], e1 = F.ROUTE_E[2 * t + 1];
        const int s0 = tb[e0] * 256 + F.ROUTE_R[2 * t], s1 = tb[e1] * 256 + F.ROUTE_R[2 * t + 1];
        const float r2 = F.R2[t];
        const f32x4* hr = (const f32x4*)(F.out + (size_t)t * DM) + lane;
        unsigned long long* o0 = (unsigned long long*)(F.XG + (size_t)s0 * DM) + lane;
        unsigned long long* o1 = (unsigned long long*)(F.XG + (size_t)s1 * DM) + lane;
#pragma unroll
        for (int j = 0; j < 8; ++j) { const f32x4 v = hr[64 * j] * r2 * nw[j];
            const unsigned long long w = (unsigned long long)pk2(v[0], v[1]) | ((unsigned long long)pk2(v[2], v[3]) << 32);
            o0[64 * j] = w; o1[64 * j] = w; }
        if (lane == 0) { F.SLOT[2 * t] = s0; F.SLOT[2 * t + 1] = s1; }
    }
}
__device__ __forceinline__ void p9_final(const Frame& F) {
    const int gw = F.vcu * NWAVES + F.wave, NGW = F.G * NWAVES, lane = F.lane;
    f32x4 fw[8];
#pragma unroll
    for (int j = 0; j < 8; ++j) fw[j] = ((const f32x4*)F.final_w)[64 * j + lane];
    for (int t = gw; t < T; t += NGW) {
        const int s0 = F.SLOT[2 * t], s1 = F.SLOT[2 * t + 1];
        const float g0 = F.ROUTE_G[2 * t], g1 = F.ROUTE_G[2 * t + 1];
        f32x4* hr = (f32x4*)(F.out + (size_t)t * DM) + lane;
        const v2u* y0 = (const v2u*)(F.Y + (size_t)s0 * DM) + lane;
        const v2u* y1 = (const v2u*)(F.Y + (size_t)s1 * DM) + lane;
        f32x4 v[8]; float ss = 0.f;
#pragma unroll
        for (int j = 0; j < 8; ++j) { const v2u a = y0[64 * j], c = y1[64 * j];
            const f32x4 ya = (f32x4){bflo(a.x), bfhi(a.x), bflo(a.y), bfhi(a.y)}, yc = (f32x4){bflo(c.x), bfhi(c.x), bflo(c.y), bfhi(c.y)};
            v[j] = hr[64 * j] + ya * g0 + yc * g1;
            ss += (v[j][0] * v[j][0] + v[j][1] * v[j][1]) + (v[j][2] * v[j][2] + v[j][3] * v[j][3]); }
        const float rs = 1.0f / sqrtf(wave_sum(ss) * (1.0f / DM) + 1e-6f);
#pragma unroll
        for (int j = 0; j < 8; ++j) hr[64 * j] = v[j] * rs * fw[j];
    }
}


struct Args { const float* in[29]; float* out; unsigned char* ws; int ph_lo, ph_hi; };
__global__ void __launch_bounds__(NTHR, 2) hybrid_fwd(Args args) {
    extern __shared__ __attribute__((aligned(16))) unsigned char lds[];
    Frame F;
    F.lds = (LAS unsigned char*)lds;
    F.MISC = (volatile LAS unsigned*)(F.lds + MISC_OFF);
    F.tid = threadIdx.x; F.lane = F.tid & 63; F.wave = __builtin_amdgcn_readfirstlane(F.tid >> 6);
    F.G = gridDim.x; { const int bx = blockIdx.x; F.vcu = (F.G % 8 == 0) ? (bx % 8) * (F.G / 8) + bx / 8 : bx; }
    unsigned char* ws = args.ws;
    F.ctl = (unsigned*)(ws + WS_CTL);
    F.x = args.in[0]; F.norm1_w = args.in[1]; F.w_in = args.in[2]; F.lam_q1 = args.in[3]; F.lam_k1 = args.in[4]; F.lam_q2 = args.in[5]; F.lam_k2 = args.in[6]; F.subln_w = args.in[7];
    F.rw_mu = args.in[8]; F.rw_w0 = args.in[9]; F.rw_w_up = args.in[10]; F.rw_a0 = args.in[11]; F.rw_a_up = args.in[12]; F.rw_g_up = args.in[13]; F.rw_k_k = args.in[14]; F.rw_k_a = args.in[15];
    F.rw_r_k = args.in[16]; F.rw_lnx_w = args.in[17]; F.rw_lnx_b = args.in[18]; F.w_out = args.in[19]; F.norm2_w = args.in[20]; F.rg_w = args.in[21]; F.rg_b = args.in[22]; F.re_w = args.in[23];
    F.re_b = args.in[24]; F.moe_w1 = args.in[25]; F.moe_w3 = args.in[26]; F.moe_w2 = args.in[27]; F.final_w = args.in[28];
    F.out = args.out;
    F.WIN = (bf16*)(ws + WS_WIN); F.WOUT = (bf16*)(ws + WS_WOUT); F.W13 = (bf16*)(ws + WS_W13); F.W2 = (bf16*)(ws + WS_W2);
    F.XN = (bf16*)(ws + WS_XN); F.MIX = (bf16*)(ws + WS_XN); F.Z = (bf16*)(ws + WS_Z); F.XG = (bf16*)(ws + WS_Z);
    F.STREAM = (bf16*)(ws + WS_STREAM); F.Y = (bf16*)(ws + WS_STREAM); F.HID = (bf16*)(ws + WS_HID);
    unsigned char* sm = ws + WS_SMALL;
    F.WUP = (bf16*)(sm + SM_WUP); F.AUP = (bf16*)(sm + SM_AUP); F.GUP = (bf16*)(sm + SM_GUP); F.WRT = (float*)(sm + SM_WRT); F.BONUS = (float*)(sm + SM_BONUS);
    F.ROUTE_E = (int*)(sm + SM_ROUTE_E); F.ROUTE_R = (int*)(sm + SM_ROUTE_R); F.ROUTE_G = (float*)(sm + SM_ROUTE_G); F.R2 = (float*)(sm + SM_R2); F.SLOT = (int*)(sm + SM_SLOT); F.TILEE = (int*)(sm + SM_TILEE);

    const int lo = args.ph_lo, hi = args.ph_hi;
    for (int u = F.tid; u < 64; u += NTHR) F.MISC[u] = 0u;
    __syncthreads();
    XcdBarrier bar; bar.bar = F.ctl + CW_BAR; bar.x = 0; bar.st = nullptr;
    if (hi - lo > 1) bar = xcd_barrier_post(F.ctl + CW_BAR, F.MISC + 8);
#define IN(k) (lo <= (k) && (k) < hi)
#define DUP(k) (DUP_PHASE == (k))
    unsigned long long st_t0 = 0, st_acc = 0; const bool st_me = (STALL_PHASE >= 0) && blockIdx.x == 0 && F.tid == 0;
#define TS(k) do { if (STALL_PHASE == (k) && st_me) st_t0 = __builtin_amdgcn_s_memrealtime(); } while (0)
#define TE(k) do { if (STALL_PHASE == (k) && st_me) st_acc += __builtin_amdgcn_s_memrealtime() - st_t0; } while (0)
#define SEAM(k) do { if (IN(k) && IN((k) + 1)) { if ((k) == 0) cg::this_grid().sync(); else xcd_barrier(bar); } } while (0)

    TS(0);
    if (IN(0)) { p0_prologue(F); if (DUP(0)) { __syncthreads(); p0_prologue(F); } SEAM(0); }
    TE(0);
    TS(1);
    if (IN(1)) {
        pg8::Gemm g{F.XN, F.WIN, T, INC, DM}; pg8::StaticOrder S; S.init(T, INC, F.G, (int)blockIdx.x);
        pg8::EpiBf16<0> E{F.Z, INC, nullptr, 0, 0, 1.0f};
        pg8::gemm_phase<pg8::EpiBf16<0>, pg8::StaticOrder, true, true>(F.lds, g, S, E);
        if (DUP(1)) { __syncthreads(); pg8::gemm_phase<pg8::EpiBf16<0>, pg8::StaticOrder, true, true>(F.lds, g, S, E); }
        SEAM(1);
    }
    TE(1);
    TS(2);
    if (IN(2)) { for (int u = F.vcu; u < T / 16; u += F.G) prep_unit(F, u, true); if (DUP(2)) { for (int u = F.vcu; u < T / 16; u += F.G) prep_unit(F, u, false); } SEAM(2); }
    TE(2);
    TS(3);
    if (IN(3)) { p3_mix(F, CW_QHEAD); if (DUP(3)) { p3_mix(F, CW_QHEAD + 1); } SEAM(3); }
    TE(3);
    TS(4);
    if (IN(4)) {
        pg8::Gemm g{F.MIX, F.WOUT, T, DM, DM}; pg8::StaticOrder S; S.init(T, DM, F.G, (int)blockIdx.x);
        pg8::EpiF32Res E{F.x, F.out, DM};
        pg8::gemm_phase<pg8::EpiF32Res, pg8::StaticOrder, true, true>(F.lds, g, S, E);
        if (DUP(4)) { __syncthreads(); pg8::gemm_phase<pg8::EpiF32Res, pg8::StaticOrder, true, true>(F.lds, g, S, E); }
        SEAM(4);
    }
    TE(4);
    TS(5);
    if (IN(5)) { for (int tl = F.vcu; tl < T / 64; tl += F.G) router_tile(F, tl, CW_CNT); if (DUP(5)) { for (int tl = F.vcu; tl < T / 64; tl += F.G) router_tile(F, tl, CW_CNT + 64); } SEAM(5); }
    TE(5);
    TS(6);
    if (IN(6)) { p6_gather(F); if (DUP(6)) { p6_gather(F); } SEAM(6); }
    TE(6);
    TS(7);
    if (IN(7)) {
        const int nT = __builtin_amdgcn_readfirstlane((int)__hip_atomic_load(F.ctl + CW_NT, __ATOMIC_RELAXED, __HIP_MEMORY_SCOPE_AGENT));
        pg8::Gemm g{F.XG, F.W13, PMAX, NE * 1024, DM}; pg8::MoeOrder S{F.TILEE, nT * 4, 4, F.G, (int)blockIdx.x};
        pg8::EpiSwiGLU E{F.HID};
        pg8::gemm_phase<pg8::EpiSwiGLU, pg8::MoeOrder, true, true>(F.lds, g, S, E);
        if (DUP(7)) { __syncthreads(); pg8::gemm_phase<pg8::EpiSwiGLU, pg8::MoeOrder, true, true>(F.lds, g, S, E); }
        SEAM(7);
    }
    TE(7);
    TS(8);
    if (IN(8)) {
        const int nT = __builtin_amdgcn_readfirstlane((int)__hip_atomic_load(F.ctl + CW_NT, __ATOMIC_RELAXED, __HIP_MEMORY_SCOPE_AGENT));
        pg8::Gemm g{F.HID, F.W2, PMAX, NE * 2048, DE}; pg8::MoeOrder S{F.TILEE, nT * 8, 8, F.G, (int)blockIdx.x};
        pg8::EpiBf16<0> E{F.Y, DM, nullptr, 2048, 0, 1.0f};
        pg8::gemm_phase<pg8::EpiBf16<0>, pg8::MoeOrder, true, true>(F.lds, g, S, E);
        if (DUP(8)) { __syncthreads(); pg8::gemm_phase<pg8::EpiBf16<0>, pg8::MoeOrder, true, true>(F.lds, g, S, E); }
        SEAM(8);
    }
    if (DUP(10)) { for (int i = 0; i < 10; ++i) xcd_barrier(bar); }
    TE(8);
    TS(9);
    if (IN(9)) { p9_final(F); }
    TE(9);
    if (st_me) { const unsigned long long t1 = __builtin_amdgcn_s_memrealtime(); while (__builtin_amdgcn_s_memrealtime() - t1 < st_acc) __builtin_amdgcn_s_sleep(8); }
#undef IN
#undef SEAM
}

extern "C" void kernel_launch(void* const* d_in, const int* in_sizes, int n_in, void* d_out, int out_size, void* d_ws, size_t ws_size, hipStream_t stream) {
    static int grid = 0;
    if (grid == 0) {
        if (n_in != 29 || in_sizes[0] != T * DM || out_size != T * DM || ws_size < WS_END) {
            fprintf(stderr, "kernel_launch: unexpected shapes (n_in %d, in0 %d, out %d, ws %zu; need ws >= %zu); nothing launched\n", n_in, n_in > 0 ? in_sizes[0] : -1, out_size, ws_size, (size_t)WS_END);
            grid = -1; return; }
        int dev = 0, cus = 0, per_cu = 0;
        if (hipGetDevice(&dev) != hipSuccess || hipDeviceGetAttribute(&cus, hipDeviceAttributeMultiprocessorCount, dev) != hipSuccess) { fprintf(stderr, "kernel_launch: device query failed\n"); grid = -1; return; }
        if (hipFuncSetAttribute((const void*)hybrid_fwd, hipFuncAttributeMaxDynamicSharedMemorySize, LDS_BYTES) != hipSuccess) { fprintf(stderr, "kernel_launch: hipFuncSetAttribute failed\n"); grid = -1; return; }
        if (hipOccupancyMaxActiveBlocksPerMultiprocessor(&per_cu, (const void*)hybrid_fwd, NTHR, LDS_BYTES) != hipSuccess || per_cu < 1) {
            fprintf(stderr, "kernel_launch: occupancy query reports %d blocks per CU\n", per_cu); (void)hipGetLastError(); per_cu = 1; }
        grid = cus;
        fprintf(stderr, "kernel_launch: grid %d (per_cu query %d), launches %d\n", grid, per_cu, N_LAUNCHES);
    }
    if (grid < 0) return;
    (void)hipMemsetAsync((char*)d_ws + WS_CTL, 0, CTL_ZERO_BYTES, stream);
    Args a{};
    for (int i = 0; i < 29; ++i) a.in[i] = (const float*)d_in[i];
    a.out = (float*)d_out; a.ws = (unsigned char*)d_ws;
    if (N_LAUNCHES == 1) {
        a.ph_lo = 0; a.ph_hi = NPHASE;
        void* kargs[] = {&a};
        hipError_t e = hipLaunchCooperativeKernel((const void*)hybrid_fwd, dim3(grid), dim3(NTHR), kargs, LDS_BYTES, stream);
        if (e != hipSuccess) fprintf(stderr, "kernel_launch: cooperative launch failed: %s (grid %d)\n", hipGetErrorString(e), grid);
    } else {
        for (int ph = 0; ph < NPHASE; ++ph) {
            a.ph_lo = ph; a.ph_hi = ph + 1;
            hipLaunchKernelGGL(hybrid_fwd, dim3(grid), dim3(NTHR), LDS_BYTES, stream, a);
            const hipError_t le = hipPeekAtLastError();
            if (le != hipSuccess) { fprintf(stderr, "kernel_launch: launch %d failed: %s\n", ph, hipGetErrorName(le)); break; }
        }
    }
}
```

```cpp
#include <hip/hip_runtime.h>
#include <hip/hip_cooperative_groups.h>
#include <cstdio>
#include <cstdint>
#include <cmath>
namespace cg = cooperative_groups;

#ifndef MK_N_LAUNCHES
#define MK_N_LAUNCHES 1
#endif

#ifndef DUP_PHASE
#define DUP_PHASE -1
#endif

#ifndef STALL_PHASE
#define STALL_PHASE -1
#endif

namespace pg8 {
#define PG8_LAS __attribute__((address_space(3)))
typedef unsigned short bf16_t;
typedef short bf16x8 __attribute__((ext_vector_type(8)));
typedef float f32x4 __attribute__((ext_vector_type(4)));
typedef unsigned u32x4 __attribute__((ext_vector_type(4)));
constexpr int BM = 256, BK = 64, HALF = 128, HTB = HALF * BK * 2  , STAGE_BYTES = 8 * HTB, NXCD = 8, WGM = 8;

__host__ __device__ __forceinline__ int lds_byte(int r, int c) { const int st = (r >> 4) * 2 + (c >> 5), rr = r & 15, cc = c & 31, ob = rr * 64 + cc * 2; return st * 1024 + (ob ^ (((ob >> 9) & 1) << 5)); }
__host__ __device__ __forceinline__ void stage_rc(int b, int& R, int& C) { const int st = b / 1024, sb = b % 1024, swz = sb ^ (((sb >> 9) & 1) << 5); R = (st >> 1) * 16 + swz / 64; C = (st & 1) * 32 + (swz % 64) / 2; }
__host__ __device__ __forceinline__ int perm32(int rho) { const int n = rho >> 4, i = rho & 15; return 8 * (i >> 2) + 4 * n + (i & 3); }

struct Unit { int pm, pn; };
struct Gemm { const bf16_t* A; const bf16_t* Bt; int M, N, K; };

struct StaticOrder {
    int nM, nN, nwg, G, c;
    __host__ __device__ void init(int M, int N, int G_, int c_) { nM = M / BM; nN = N / BM; nwg = nM * nN; G = G_; c = c_; }
    __host__ __device__ bool next(int i, Unit& u) const {
        const long L = (long)i * G + c; if (L >= nwg) return false;
        int wgid = (int)L; { const int q = nwg / NXCD, r = nwg % NXCD, xcd = wgid % NXCD, off = wgid / NXCD; wgid = (xcd < r ? xcd * (q + 1) : r * (q + 1) + (xcd - r) * q) + off; }
        const int nig = WGM * nN, gid = wgid / nig, fm = gid * WGM, gsz = (nM - fm) < WGM ? (nM - fm) : WGM;
        u.pm = fm + ((wgid % nig) % gsz); u.pn = (wgid % nig) / gsz; return true;
    }
    __device__ __forceinline__ void a_ready(const Unit&) const {}
    __device__ __forceinline__ void done(const Unit&) const {}
};

__device__ __forceinline__ unsigned cvt_pk_bf16(float lo, float hi) { unsigned r; asm volatile("v_cvt_pk_bf16_f32 %0, %1, %2" : "=v"(r) : "v"(lo), "v"(hi)); return r; }
typedef float f32x2 __attribute__((ext_vector_type(2)));
__device__ __forceinline__ f32x2 gelu_pk(f32x2 v) {
    const f32x2 av = __builtin_elementwise_abs(v), d = av * 0.2316418882f + 1.0f;
    f32x2 t; t.x = __builtin_amdgcn_rcpf(d.x); t.y = __builtin_amdgcn_rcpf(d.y);
    f32x2 q = t * 0.5307027145f + (-0.7265760135f); q = q * t + 0.7107068705f; q = q * t + (-0.142248368f); q = q * t + 0.127414796f; q = q * t;
    const f32x2 s = (v * v) * (-0.72134752044f);
    f32x2 e; e.x = __builtin_amdgcn_exp2f(s.x); e.y = __builtin_amdgcn_exp2f(s.y);
    const f32x2 m = v * (q * e), r = v - m;
    f32x2 o; o.x = v.x < 0.f ? m.x : r.x; o.y = v.y < 0.f ? m.y : r.y; return o;
}

template <int ACT  > struct EpiBf16 {
    static constexpr bool PERM = true, AFTER_DRAIN = false; static_assert(ACT == 0 || ACT == 1, "EpiBf16: ACT is 0 (none) or 1 (gelu_pk)");
    bf16_t* O; int ldc; const float* bias; int split_cols; size_t split_stride; float scale0;
    __device__ __forceinline__ void operator()(const f32x4 (&acc)[2][2][4][2], const Unit& u, int wr, int wc, int fr, int fq) const {
        const int row0 = u.pm * BM + wr * 64 + fr; int colt = u.pn * BM; bf16_t* base = O;
        float sc = 1.f; if (split_cols) { const int t = colt / split_cols; base += (size_t)t * split_stride; colt -= t * split_cols; if (t == 0) sc = scale0; }
        const int col0 = colt + wc * 32 + 8 * fq, bcol0 = u.pn * BM + wc * 32 + 8 * fq;
        f32x4 bv[2][2];
#pragma unroll
        for (int bj = 0; bj < 2; ++bj)
#pragma unroll
            for (int n = 0; n < 2; ++n) bv[bj][n] = bias ? *(const f32x4*)(bias + bcol0 + bj * HALF + 4 * n) : (f32x4){0.f, 0.f, 0.f, 0.f};
#pragma unroll
        for (int ai = 0; ai < 2; ++ai)
#pragma unroll
            for (int m = 0; m < 4; ++m) { bf16_t* rowp = base + (size_t)(row0 + ai * HALF + m * 16) * ldc + col0;
#pragma unroll
                for (int bj = 0; bj < 2; ++bj) { f32x4 v0 = acc[ai][bj][m][0] + bv[bj][0], v1 = acc[ai][bj][m][1] + bv[bj][1];
                    if (ACT == 1) { f32x2 a = gelu_pk((f32x2){v0[0], v0[1]}), b = gelu_pk((f32x2){v0[2], v0[3]}), c = gelu_pk((f32x2){v1[0], v1[1]}), d = gelu_pk((f32x2){v1[2], v1[3]});
                        v0 = (f32x4){a.x, a.y, b.x, b.y}; v1 = (f32x4){c.x, c.y, d.x, d.y}; }
                    v0 = v0 * sc; v1 = v1 * sc; u32x4 w; w.x = cvt_pk_bf16(v0[0], v0[1]); w.y = cvt_pk_bf16(v0[2], v0[3]); w.z = cvt_pk_bf16(v1[0], v1[1]); w.w = cvt_pk_bf16(v1[2], v1[3]);
                    *(u32x4*)(rowp + bj * HALF) = w; } }
    }
};

struct EpiF32Res {
    static constexpr bool PERM = false, AFTER_DRAIN = false;
    const float* base; float* out; int ldc;
    __device__ __forceinline__ void operator()(const f32x4 (&acc)[2][2][4][2], const Unit& u, int wr, int wc, int fr, int fq) const {
        const int row0 = u.pm * BM + wr * 64 + fr, col0 = u.pn * BM + wc * 32 + 4 * fq;
#pragma unroll
        for (int ai = 0; ai < 2; ++ai)
#pragma unroll
            for (int m = 0; m < 4; ++m) { const size_t off = (size_t)(row0 + ai * HALF + m * 16) * ldc + col0;
#pragma unroll
                for (int bj = 0; bj < 2; ++bj)
#pragma unroll
                    for (int n = 0; n < 2; ++n) { const f32x4 bs = *(const f32x4*)(base + off + bj * HALF + n * 16); *(f32x4*)(out + off + bj * HALF + n * 16) = bs + acc[ai][bj][m][n]; } }
    }
};
struct EpiSwiGLU {
    static constexpr bool PERM = true, AFTER_DRAIN = false;
    bf16_t* O;
    __device__ __forceinline__ void operator()(const f32x4 (&acc)[2][2][4][2], const Unit& u, int wr, int wc, int fr, int fq) const {
        const int row0 = u.pm * BM + wr * 64 + fr; const int col0 = (u.pn & 3) * HALF + wc * 32 + 8 * fq;
#pragma unroll
        for (int ai = 0; ai < 2; ++ai)
#pragma unroll
            for (int m = 0; m < 4; ++m) { bf16_t* rowp = O + (size_t)(row0 + ai * HALF + m * 16) * 512 + col0;
                float o[8];
#pragma unroll
                for (int n = 0; n < 2; ++n)
#pragma unroll
                    for (int i = 0; i < 4; ++i) { const float a = acc[ai][0][m][n][i], b = acc[ai][1][m][n][i]; o[n * 4 + i] = a * __builtin_amdgcn_rcpf(1.0f + __expf(-a)) * b; }
                u32x4 w; w.x = cvt_pk_bf16(o[0], o[1]); w.y = cvt_pk_bf16(o[2], o[3]); w.z = cvt_pk_bf16(o[4], o[5]); w.w = cvt_pk_bf16(o[6], o[7]);
                *(u32x4*)rowp = w; }
    }
};
struct MoeOrder {
    const int* tileE; int nunits, ncol, G, c;
    __device__ __forceinline__ bool next(int i, Unit& u) const {
        const int L = i * G + c; if (L >= nunits) return false;
        const int pm = L / ncol; const int e = __builtin_amdgcn_readfirstlane(tileE[pm]);
        u.pm = pm; u.pn = e * ncol + (L - pm * ncol); return true;
    }
    __device__ __forceinline__ void a_ready(const Unit&) const {}
    __device__ __forceinline__ void done(const Unit&) const {}
};

template <class Epi, class Sched, bool ALIGN_EPI = false, bool SP2 = false>
__device__ __forceinline__ void gemm_phase(PG8_LAS unsigned char* lds, const Gemm g, const Sched& S, const Epi& E) {
    const int tid = threadIdx.x, wid = __builtin_amdgcn_readfirstlane(tid >> 6), lane = tid & 63, wr = wid >> 2, wc = wid & 3, fr = lane & 15, fq = lane >> 4;
    const int K = g.K, nt = K / BK;
    unsigned voffA[2], voffB[2];
#pragma unroll
    for (int i = 0; i < 2; ++i) { int R, C; stage_rc(tid * 16 + i * 8192, R, C); const int Rb = Epi::PERM ? ((R & ~31) + perm32(R & 31)) : R;
        voffA[i] = (unsigned)(R * K + C) * 2u; voffB[i] = (unsigned)(Rb * K + C) * 2u; }
    const size_t kstep = (size_t)(BK * 2);
    const size_t hstep = (size_t)HALF * K * 2;
    const size_t tstep = 2 * hstep;
    const unsigned ldsw = (unsigned)wid * 1024u;
    const int aoff = lds_byte(wr * 64 + fr, fq * 8), boff = lds_byte(wc * 32 + fr, fq * 8);
#define PG8_SA(b, h) (((b) * 2 + (h)) * HTB)
#define PG8_SB(b, h) ((4 + (b) * 2 + (h)) * HTB)
#define PG8_STAGE(bufoff, gbase, voff) do { _Pragma("unroll") for (int _i = 0; _i < 2; ++_i) \
        __builtin_amdgcn_global_load_lds((const unsigned*)((const char*)(gbase) + (voff)[_i]), (PG8_LAS unsigned*)(lds + (bufoff) + ldsw + _i * 8192), 16, 0, 0); } while (0)
#define PG8_LDA(dst, b, h) do { _Pragma("unroll") for (int m = 0; m < 4; ++m) _Pragma("unroll") for (int k = 0; k < 2; ++k) dst[m][k] = *(const PG8_LAS bf16x8*)(lds + PG8_SA(b, h) + aoff + m * 2048 + k * 1024); } while (0)
#define PG8_LDB(dst, b, h) do { _Pragma("unroll") for (int n = 0; n < 2; ++n) _Pragma("unroll") for (int k = 0; k < 2; ++k) dst[n][k] = *(const PG8_LAS bf16x8*)(lds + PG8_SB(b, h) + boff + n * 2048 + k * 1024); } while (0)
#define PG8_MMA(ai, bj, At, Bt) do { __builtin_amdgcn_s_setprio(1); _Pragma("unroll") for (int m = 0; m < 4; ++m) _Pragma("unroll") for (int n = 0; n < 2; ++n) _Pragma("unroll") for (int k = 0; k < 2; ++k) \
        acc[ai][bj][m][n] = __builtin_amdgcn_mfma_f32_16x16x32_bf16(Bt[n][k], At[m][k], acc[ai][bj][m][n], 0, 0, 0); __builtin_amdgcn_s_setprio(0); } while (0)
#define PG8_WAIT_V(n) asm volatile("s_waitcnt vmcnt(" #n ")" ::: "memory")
#define PG8_WAIT_L(n) asm volatile("s_waitcnt lgkmcnt(" #n ")" ::: "memory")
#define PG8_BAR __builtin_amdgcn_s_barrier()
#define PG8_SCHED __builtin_amdgcn_sched_barrier(0)
    Unit cur, nxt; int ui = 0;
    if (!S.next(0, cur)) return;
    f32x4 acc[2][2][4][2];
#pragma unroll
    for (int a = 0; a < 2; ++a)
#pragma unroll
        for (int b = 0; b < 2; ++b)
#pragma unroll
            for (int m = 0; m < 4; ++m)
#pragma unroll
                for (int n = 0; n < 2; ++n) acc[a][b][m][n] = (f32x4){0.f, 0.f, 0.f, 0.f};
    bf16x8 At[4][2], B0[2][2], B1[2][2];
    const char* cA = (const char*)g.A + (size_t)cur.pm * tstep; const char* cB = (const char*)g.Bt + (size_t)cur.pn * tstep;
    S.a_ready(cur);
    if constexpr (SP2) {
        PG8_STAGE(PG8_SB(0, 0), cB, voffB); PG8_STAGE(PG8_SB(0, 1), cB + hstep, voffB); PG8_STAGE(PG8_SA(0, 0), cA, voffA); PG8_STAGE(PG8_SA(0, 1), cA + hstep, voffA);
        if (wr == 1) PG8_BAR;
        PG8_WAIT_V(2); PG8_BAR;
        PG8_STAGE(PG8_SB(1, 0), cB + kstep, voffB); PG8_STAGE(PG8_SA(1, 0), cA + kstep, voffA); PG8_STAGE(PG8_SB(1, 1), cB + hstep + kstep, voffB);
        PG8_WAIT_V(6); PG8_BAR;
    } else {
        PG8_STAGE(PG8_SB(0, 0), cB, voffB); PG8_STAGE(PG8_SA(0, 0), cA, voffA); PG8_STAGE(PG8_SB(0, 1), cB + hstep, voffB); PG8_STAGE(PG8_SA(0, 1), cA + hstep, voffA);
        if (wr == 1) PG8_BAR;
        PG8_WAIT_V(4); PG8_BAR;
        PG8_STAGE(PG8_SB(1, 0), cB + kstep, voffB); PG8_STAGE(PG8_SA(1, 0), cA + kstep, voffA); PG8_STAGE(PG8_SB(1, 1), cB + hstep + kstep, voffB);
        PG8_WAIT_V(6); PG8_BAR;
    }
    for (;;) {
        const bool has_next = S.next(ui + 1, nxt);
        const char* nA = has_next ? (const char*)g.A + (size_t)nxt.pm * tstep : cA; const char* nB = has_next ? (const char*)g.Bt + (size_t)nxt.pn * tstep : cB;
        for (int t = 0; t < nt; t += 2) {
            const bool last = (t == nt - 2);
            const char* a1 = cA + (size_t)(t + 1) * kstep;
            const char* a2 = last ? nA : cA + (size_t)(t + 2) * kstep; const char* b2 = last ? nB : cB + (size_t)(t + 2) * kstep;
            const char* a3 = a2 + kstep; const char* b3 = b2 + kstep;
            if (last && has_next) S.a_ready(nxt);
            if constexpr (SP2) {
            PG8_LDB(B0, 0, 0); PG8_LDB(B1, 0, 1); PG8_SCHED; PG8_LDA(At, 0, 0); PG8_STAGE(PG8_SA(1, 1), a1 + hstep, voffA);
            PG8_WAIT_V(8); PG8_WAIT_L(0); PG8_BAR; PG8_MMA(0, 0, At, B0); PG8_MMA(0, 1, At, B1); PG8_BAR; PG8_SCHED;
            PG8_LDA(At, 0, 1); PG8_STAGE(PG8_SB(0, 0), b2, voffB); PG8_STAGE(PG8_SB(0, 1), b2 + hstep, voffB); PG8_STAGE(PG8_SA(0, 0), a2, voffA);
            PG8_WAIT_V(8); PG8_WAIT_L(0); PG8_BAR; PG8_MMA(1, 0, At, B0); PG8_MMA(1, 1, At, B1); PG8_BAR; PG8_SCHED;
            PG8_LDB(B0, 1, 0); PG8_LDB(B1, 1, 1); PG8_SCHED; PG8_LDA(At, 1, 0); PG8_STAGE(PG8_SA(0, 1), a2 + hstep, voffA);
            PG8_WAIT_V(8); PG8_WAIT_L(0); PG8_BAR; PG8_MMA(0, 0, At, B0); PG8_MMA(0, 1, At, B1); PG8_BAR; PG8_SCHED;
            PG8_LDA(At, 1, 1); PG8_STAGE(PG8_SB(1, 0), b3, voffB); PG8_STAGE(PG8_SB(1, 1), b3 + hstep, voffB); PG8_STAGE(PG8_SA(1, 0), a3, voffA);
            PG8_WAIT_V(8); PG8_WAIT_L(0); PG8_BAR; PG8_MMA(1, 0, At, B0); PG8_MMA(1, 1, At, B1); PG8_BAR; PG8_SCHED;
            } else {
            PG8_LDB(B0, 0, 0); PG8_SCHED; PG8_LDA(At, 0, 0); PG8_STAGE(PG8_SA(1, 1), a1 + hstep, voffA);
            PG8_WAIT_L(8); PG8_BAR; PG8_WAIT_L(0); PG8_MMA(0, 0, At, B0); PG8_BAR; PG8_SCHED;
            PG8_LDB(B1, 0, 1); PG8_STAGE(PG8_SB(0, 0), b2, voffB);
            PG8_BAR; PG8_WAIT_L(0); PG8_MMA(0, 1, At, B1); PG8_BAR;
            PG8_LDA(At, 0, 1); PG8_STAGE(PG8_SA(0, 0), a2, voffA);
            PG8_BAR; PG8_WAIT_L(0); PG8_MMA(1, 0, At, B0); PG8_BAR; PG8_SCHED;
            PG8_STAGE(PG8_SB(0, 1), b2 + hstep, voffB);
            PG8_WAIT_V(6); PG8_BAR; PG8_MMA(1, 1, At, B1); PG8_BAR;
            PG8_LDB(B0, 1, 0); PG8_SCHED; PG8_LDA(At, 1, 0); PG8_STAGE(PG8_SA(0, 1), a2 + hstep, voffA);
            PG8_WAIT_L(8); PG8_BAR; PG8_WAIT_L(0); PG8_MMA(0, 0, At, B0); PG8_BAR; PG8_SCHED;
            PG8_LDB(B1, 1, 1); PG8_STAGE(PG8_SB(1, 0), b3, voffB);
            PG8_BAR; PG8_WAIT_L(0); PG8_MMA(0, 1, At, B1); PG8_BAR;
            PG8_LDA(At, 1, 1); PG8_STAGE(PG8_SA(1, 0), a3, voffA);
            PG8_BAR; PG8_WAIT_L(0); PG8_MMA(1, 0, At, B0); PG8_BAR; PG8_SCHED;
            PG8_STAGE(PG8_SB(1, 1), b3 + hstep, voffB);
            PG8_WAIT_V(6); PG8_BAR; PG8_MMA(1, 1, At, B1); PG8_BAR;
            }
        }
        if constexpr (ALIGN_EPI) { if (wr == 0) PG8_BAR; }
        if constexpr (!Epi::AFTER_DRAIN) { E(acc, cur, wr, wc, fr, fq); S.done(cur); }
        if (!has_next) break;
#pragma unroll
        for (int a = 0; a < 2; ++a)
#pragma unroll
            for (int b = 0; b < 2; ++b)
#pragma unroll
                for (int m = 0; m < 4; ++m)
#pragma unroll
                    for (int n = 0; n < 2; ++n) acc[a][b][m][n] = (f32x4){0.f, 0.f, 0.f, 0.f};
        cur = nxt; cA = nA; cB = nB; ++ui;
        if constexpr (ALIGN_EPI) { if (wr == 1) PG8_BAR; }
    }
    PG8_WAIT_V(0);
    if constexpr (!ALIGN_EPI) { if (wr == 0) PG8_BAR; }
    PG8_BAR;
    if constexpr (Epi::AFTER_DRAIN) { E.fused(acc, cur, wr, wc, fr, fq, lds, wid, lane); S.done(cur); }
#undef PG8_SA
#undef PG8_SB
#undef PG8_STAGE
#undef PG8_LDA
#undef PG8_LDB
#undef PG8_MMA
#undef PG8_WAIT_V
#undef PG8_WAIT_L
#undef PG8_BAR
#undef PG8_SCHED
}
}

constexpr int NWAVES = 8, NTHR = 512;
constexpr int BATCH = 4, SEQ = 4096, DM = 2048, T = BATCH * SEQ;
constexpr int INC = 6400;
constexpr int ZK = 1024, ZV = 2048, ZR = 3072;
constexpr int NE = 64, DE = 512;
constexpr int PMAX = 49152;
constexpr int NPHASE = 10;
constexpr int N_LAUNCHES = MK_N_LAUNCHES;
constexpr float C2 = 0.125f * 1.4426950408889634f;
constexpr float LAM_INIT = 0.2f;

constexpr size_t MiB = 1u << 20;
constexpr size_t WS_CTL = 0, CTL_ZERO_BYTES = 64 * 1024;
constexpr size_t WS_SMALL = 1 * MiB;
constexpr size_t WS_WIN = 9 * MiB;
constexpr size_t WS_WOUT = 34 * MiB;
constexpr size_t WS_W13 = 42 * MiB;
constexpr size_t WS_W2 = 298 * MiB;
constexpr size_t WS_XN = 426 * MiB;
constexpr size_t WS_Z = 490 * MiB;
constexpr size_t WS_STREAM = 690 * MiB;
constexpr size_t WS_HID = 914 * MiB;
constexpr size_t WS_END = 962 * MiB;
constexpr size_t SM_WUP = 0;
constexpr size_t SM_AUP = 128 * 1024;
constexpr size_t SM_GUP = 256 * 1024;
constexpr size_t SM_WRT = 512 * 1024;
constexpr size_t SM_ROUTE_E = 2 * MiB;
constexpr size_t SM_ROUTE_R = 2 * MiB + 128 * 1024;
constexpr size_t SM_ROUTE_G = 2 * MiB + 256 * 1024;
constexpr size_t SM_R2 = 2 * MiB + 384 * 1024;
constexpr size_t SM_SLOT = 2 * MiB + 512 * 1024;
constexpr size_t SM_TILEE = 3 * MiB;
constexpr size_t SM_SC = 3 * MiB + 64 * 1024;
constexpr int CW_QHEAD = 64;
constexpr int CW_NT = 128;
constexpr int CW_BAR = 4096;
constexpr int CW_CNT = 256;

constexpr int RING_BYTES = 131072;
constexpr int MISC_OFF = RING_BYTES;
constexpr int LDS_BYTES = 147456;

#define GAS __attribute__((address_space(1)))
#define LAS __attribute__((address_space(3)))
typedef unsigned short bf16;
typedef unsigned v4u __attribute__((ext_vector_type(4)));
typedef unsigned v2u __attribute__((ext_vector_type(2)));
typedef float f32x4 __attribute__((ext_vector_type(4)));
typedef float f32x16 __attribute__((ext_vector_type(16)));
typedef short bf16x8 __attribute__((ext_vector_type(8)));
typedef short s16x4 __attribute__((ext_vector_type(4)));

__device__ __forceinline__ unsigned f2bf(float f) { unsigned u = __builtin_bit_cast(unsigned, f); return (u + 0x7fffu + ((u >> 16) & 1u)) >> 16; }
__device__ __forceinline__ unsigned pk2(float lo, float hi) { return f2bf(lo) | (f2bf(hi) << 16); }
__device__ __forceinline__ float bf2f(unsigned b) { return __builtin_bit_cast(float, b << 16); }
__device__ __forceinline__ float bflo(unsigned w) { return __builtin_bit_cast(float, w << 16); }
__device__ __forceinline__ float bfhi(unsigned w) { return __builtin_bit_cast(float, w & 0xffff0000u); }
__device__ __forceinline__ float wave_sum(float v) {
#pragma unroll
    for (int o = 1; o < 64; o <<= 1) v += __shfl_xor(v, o);
    return v;
}
template <int CTRL> __device__ __forceinline__ float dpp_mov(float x) { return __builtin_bit_cast(float, __builtin_amdgcn_update_dpp(0, __builtin_bit_cast(int, x), CTRL, 0xF, 0xF, true)); }
__device__ __forceinline__ float reduce16(float x) {
    x += dpp_mov<0xB1>(x);
    x += dpp_mov<0x4E>(x);
    x += dpp_mov<0x141>(x);
    x += dpp_mov<0x140>(x);
    return x;
}
__device__ __forceinline__ float sigmoidf_(float x) { return __builtin_amdgcn_rcpf(1.0f + __expf(-x)); }

#define RLX_AGENT __ATOMIC_RELAXED, __HIP_MEMORY_SCOPE_AGENT
#define XB_TMO      128
#define XB_XCNT(j)  (256  + 64 * (j))
#define XB_XSUB(j)  (1280 + 64 * (j))
#define XB_XGEN(j)  (2304 + 64 * (j))
#define XB_TOP      3328
#define XB_TOPGEN   3392
#define XCD_BAR_WORDS 3456
#define XB_SPIN_CAP (1u << 18)

__device__ __forceinline__ unsigned xb_ld(unsigned* p)              { return __hip_atomic_load(p, __ATOMIC_RELAXED, __HIP_MEMORY_SCOPE_AGENT); }
__device__ __forceinline__ unsigned xb_add(unsigned* p, unsigned v) { return __hip_atomic_fetch_add(p, v, __ATOMIC_RELAXED, __HIP_MEMORY_SCOPE_AGENT); }
__device__ __forceinline__ unsigned xb_xcc_id() { return (unsigned)__builtin_amdgcn_s_getreg((3 << 11) | 20) & 0xFu; }
#define XB_SPIN(cond, bar) do { unsigned _sp = 0; while (cond) { __builtin_amdgcn_s_sleep(1); \
    if ((++_sp & 255u) == 0u) { if (xb_ld(&(bar)[XB_TMO])) break; if (_sp > XB_SPIN_CAP) { atomicAdd(&(bar)[XB_TMO], 1u); break; } } } } while (0)

struct XcdBarrier {
    unsigned* bar; unsigned x;
    volatile LAS unsigned* st;
};

__device__ __forceinline__ XcdBarrier xcd_barrier_post(unsigned* bar, volatile LAS unsigned* st) {
    XcdBarrier b; b.bar = bar; b.x = xb_xcc_id(); b.st = st;
    if (threadIdx.x == 0) (void)xb_add(&bar[XB_XCNT(b.x)], 1u);
    return b;
}
__device__ __forceinline__ void xcd_barrier_complete(unsigned* bar, unsigned x, unsigned& nloc, unsigned& nx) {
    const unsigned G = gridDim.x * gridDim.y * gridDim.z;
    unsigned sum, cnt, mine, sp = 0u;
    for (;;) {
        sum = 0u; cnt = 0u; mine = 0u;
#pragma unroll
        for (unsigned j = 0; j < 16; ++j) { const unsigned c = xb_ld(&bar[XB_XCNT(j)]); sum += c; cnt += (c > 0u) ? 1u : 0u; mine = (j == x) ? c : mine; }
        if (sum == G) break;
        __builtin_amdgcn_s_sleep(1);
        if ((++sp & 255u) == 0u) { if (xb_ld(&bar[XB_TMO])) break; if (sp > XB_SPIN_CAP) { atomicAdd(&bar[XB_TMO], 1u); break; } }
    }
    nloc = mine > 0u ? mine : 1u; nx = cnt > 0u ? cnt : 1u;
}

__device__ __forceinline__ void xcd_barrier(const XcdBarrier& b) {
    asm volatile("s_waitcnt vmcnt(0)" ::: "memory");
    __syncthreads();
    if (threadIdx.x == 0) {
        unsigned* bar = b.bar;
        __builtin_amdgcn_s_waitcnt(0);
        unsigned nloc = b.st[0], nx = b.st[1];
        if (nloc == 0u) { xcd_barrier_complete(bar, b.x, nloc, nx); b.st[0] = nloc; b.st[1] = nx; }
        const unsigned old = xb_add(&bar[XB_XSUB(b.x)], 1u);
        const unsigned gen = old / nloc;
        if (old + 1u == (gen + 1u) * nloc) {
            __builtin_amdgcn_fence(__ATOMIC_RELEASE, "agent");
            asm volatile("s_waitcnt vmcnt(0)" ::: "memory");
            const unsigned og = xb_add(&bar[XB_TOP], 1u);
            const unsigned tg = og / nx;
            if (og + 1u == (tg + 1u) * nx) xb_add(&bar[XB_TOPGEN], 1u);
            else XB_SPIN(xb_ld(&bar[XB_TOPGEN]) == tg, bar);
            __builtin_amdgcn_fence(__ATOMIC_ACQUIRE, "agent");
            xb_add(&bar[XB_XGEN(b.x)], 1u);
            asm volatile("s_waitcnt vmcnt(0)" ::: "memory");
        } else {
            XB_SPIN(xb_ld(&bar[XB_XGEN(b.x)]) == gen, bar);
            __builtin_amdgcn_fence(__ATOMIC_ACQUIRE, "agent");
            asm volatile("s_waitcnt vmcnt(0)" ::: "memory");
        }
    }
    __syncthreads();
}

struct Frame {
    LAS unsigned char* lds;
    volatile LAS unsigned* MISC;
    unsigned* ctl;
    int tid, lane, wave, vcu, G;
    const float *x, *norm1_w, *w_in, *lam_q1, *lam_k1, *lam_q2, *lam_k2, *subln_w, *rw_mu, *rw_w0, *rw_w_up, *rw_a0, *rw_a_up, *rw_g_up, *rw_k_k, *rw_k_a, *rw_r_k, *rw_lnx_w, *rw_lnx_b,
                *w_out, *norm2_w, *rg_w, *rg_b, *re_w, *re_b, *moe_w1, *moe_w3, *moe_w2, *final_w;
    float* out;
    bf16 *WIN, *WOUT, *W13, *W2, *XN, *MIX, *Z, *XG, *STREAM, *Y, *HID, *WUP, *AUP, *GUP;
    float *WRT, *SC, *ROUTE_G, *R2;
    int *ROUTE_E, *ROUTE_R, *SLOT, *TILEE;
};

__device__ __forceinline__ void p0_transpose_item(const float* W, int N, bf16* WT, int ldt, int dst_row0, int k0, int n0, const float* kscale, LAS float* scr, int lane) {
#pragma unroll 8
    for (int i = 0; i < 32; ++i) { const int kk = 2 * i + (lane >> 5); float v = W[(size_t)(k0 + kk) * N + n0 + (lane & 31)]; if (kscale) v *= kscale[k0 + kk]; scr[kk * 33 + (lane & 31)] = v; }
    asm volatile("s_waitcnt lgkmcnt(0)" ::: "memory");
    const int c = lane & 7;
#pragma unroll
    for (int j = 0; j < 4; ++j) { const int n = (lane >> 3) + 8 * j; const LAS float* s = scr + (8 * c) * 33 + n;
        v4u o; o.x = pk2(s[0 * 33], s[1 * 33]); o.y = pk2(s[2 * 33], s[3 * 33]); o.z = pk2(s[4 * 33], s[5 * 33]); o.w = pk2(s[6 * 33], s[7 * 33]);
        *(v4u*)(WT + (size_t)(dst_row0 + n) * ldt + k0 + 8 * c) = o; }
    asm volatile("s_waitcnt lgkmcnt(0)" ::: "memory");
}
constexpr int I_IN = 32 * 200, I_OUT = 32 * 64, I_W1 = 64 * 32 * 16, I_W2 = 64 * 8 * 64, I_UP = 32, I_GUP = 64;
constexpr int I_BASE = I_IN + I_OUT + 2 * I_UP + I_GUP, NITEMS = I_BASE + 2 * I_W1 + I_W2;
constexpr int MOE_WG_ITEMS = 256;
constexpr int N_MOE_QITEMS = (2 * I_W1 + I_W2) / MOE_WG_ITEMS;
__device__ __forceinline__ void convert_item(const Frame& F, int it, LAS float* scr, int lane) {
    int r = it;
    if (r < I_IN) { const int kb = r / 200, nb = r % 200; p0_transpose_item(F.w_in, INC, F.WIN, DM, 32 * nb, 64 * kb, 32 * nb, F.norm1_w, scr, lane); return; } r -= I_IN;
    if (r < I_OUT) { const int kb = r / 64, nb = r % 64; p0_transpose_item(F.w_out, DM, F.WOUT, DM, 32 * nb, 64 * kb, 32 * nb, nullptr, scr, lane); return; } r -= I_OUT;
    if (r < I_UP) { p0_transpose_item(F.rw_w_up, 1024, F.WUP, 64, 32 * r, 0, 32 * r, nullptr, scr, lane); return; } r -= I_UP;
    if (r < I_UP) { p0_transpose_item(F.rw_a_up, 1024, F.AUP, 64, 32 * r, 0, 32 * r, nullptr, scr, lane); return; } r -= I_UP;
    if (r < I_GUP) { const int kb = r / 32, nb = r % 32; p0_transpose_item(F.rw_g_up, 1024, F.GUP, 128, 32 * nb, 64 * kb, 32 * nb, nullptr, scr, lane); return; } r -= I_GUP;
    if (r < 2 * I_W1) { const int which = r / I_W1; r -= which * I_W1; const int e = r / 512, q = r % 512, kb = q / 16, nb = q % 16, n0 = 32 * nb;
        const float* W = (which ? F.moe_w3 : F.moe_w1) + (size_t)e * DM * DE;
        p0_transpose_item(W, DE, F.W13, DM, e * 1024 + (n0 >> 7) * 256 + which * 128 + (n0 & 127), 64 * kb, n0, nullptr, scr, lane); return; } r -= 2 * I_W1;
    { const int e = r / 512, q = r % 512, kb = q / 64, nb = q % 64;
      p0_transpose_item(F.moe_w2 + (size_t)e * DE * DM, DM, F.W2, DE, e * 2048 + 32 * nb, 64 * kb, 32 * nb, nullptr, scr, lane); }
}
__device__ __forceinline__ void moe_convert_qitem(const Frame& F, int qi) {
    LAS float* scr = (LAS float*)(F.lds + F.wave * 16384);
    const int base = I_BASE + qi * MOE_WG_ITEMS + F.wave * (MOE_WG_ITEMS / NWAVES);
    for (int i = 0; i < MOE_WG_ITEMS / NWAVES; ++i) convert_item(F, base + i, scr, F.lane);
}
__device__ __forceinline__ void p0_prologue(const Frame& F) {
    LAS float* scr = (LAS float*)(F.lds + F.wave * 16384);
    const int gw = F.vcu * NWAVES + F.wave, NGW = F.G * NWAVES, lane = F.lane;
    for (int it = gw; it < I_BASE; it += NGW) convert_item(F, it, scr, lane);
    for (int i = (F.vcu * NTHR + F.tid); i < 80 * DM; i += F.G * NTHR) { const int n = i / DM, k = i % DM;
        float v = 0.f; if (n < 8) v = F.rg_w[k * 8 + n]; else if (n < 72) v = F.re_w[k * 64 + (n - 8)];
        F.WRT[i] = v * F.norm2_w[k]; }
    for (int m = gw; m < T; m += NGW) {
        const f32x4* xr = (const f32x4*)(F.x + (size_t)m * DM) + lane;
        f32x4 v[8]; float s = 0.f;
#pragma unroll
        for (int j = 0; j < 8; ++j) { v[j] = xr[64 * j]; s += (v[j].x * v[j].x + v[j].y * v[j].y) + (v[j].z * v[j].z + v[j].w * v[j].w); }
        const float rs = 1.0f / sqrtf(wave_sum(s) * (1.0f / DM) + 1e-6f);
        unsigned long long* o8 = (unsigned long long*)(F.XN + (size_t)m * DM) + lane;
#pragma unroll
        for (int j = 0; j < 8; ++j) o8[64 * j] = (unsigned long long)pk2(v[j].x * rs, v[j].y * rs) | ((unsigned long long)pk2(v[j].z * rs, v[j].w * rs) << 32);
    }
}


constexpr int ST_TOK = 7 * 64;
constexpr int AT_PITCH = 264;
__device__ __forceinline__ void prep_unit(const Frame& F, int unit, bool do_rope) {
    const int tid = F.tid, lane = F.lane, wave = F.wave;
    const int row0 = unit * 16, tpos0 = row0 & (SEQ - 1), bidx = row0 >> 12;
    bf16* Z = F.Z;
    if (do_rope) {
        const int tk = tid >> 5, i = tid & 31;
        const float pos = (float)(tpos0 + tk);
        const float inv = exp2f(-(float)i * (13.287712379549449f / 32.0f));
        const float ang = pos * inv;
        const float sn = sinf(ang), cs = cosf(ang);
        bf16* zr = Z + (size_t)(row0 + tk) * INC;
#pragma unroll 4
        for (int hh = 0; hh < 32; ++hh) {
            const int col = hh * 64 + i;
            const float x1 = bf2f(zr[col]), x2 = bf2f(zr[col + 32]);
            float o1 = x1 * cs - x2 * sn, o2 = x2 * cs + x1 * sn;
            if (hh < 16) { o1 *= C2; o2 *= C2; }
            zr[col] = (bf16)f2bf(o1); zr[col + 32] = (bf16)f2bf(o2);
        }
    }
    LAS bf16* At = (LAS bf16*)F.lds;
    {
        const int tk = tid >> 5, c8 = (tid & 31) * 8;
        const bool first = (tpos0 + tk) == 0;
        const bf16* zc = Z + (size_t)(row0 + tk) * INC + ZR + 3072 + c8;
        const v4u cur = *(const v4u*)zc;
        v4u prv = (v4u){0u, 0u, 0u, 0u}; if (!first) prv = *(const v4u*)(zc - INC);
        const f32x4 mu0 = *(const f32x4*)(F.rw_mu + 3072 + c8), mu1 = *(const f32x4*)(F.rw_mu + 3072 + c8 + 4);
        float v[8];
#pragma unroll
        for (int j = 0; j < 4; ++j) { const float c0 = bflo(cur[j]), c1 = bfhi(cur[j]), p0 = bflo(prv[j]), p1 = bfhi(prv[j]);
            const float m0 = (j < 2) ? mu0[2 * j] : mu1[2 * j - 4], m1 = (j < 2) ? mu0[2 * j + 1] : mu1[2 * j - 3];
            v[2 * j] = c0 + (p0 - c0) * m0; v[2 * j + 1] = c1 + (p1 - c1) * m1; }
        if (c8 < 64) {
#pragma unroll
            for (int j = 0; j < 8; ++j) { const float e = __expf(2.0f * v[j]); v[j] = 1.0f - 2.0f * __builtin_amdgcn_rcpf(e + 1.0f); }
        } else if (c8 >= 128) {
#pragma unroll
            for (int j = 0; j < 8; ++j) v[j] = sigmoidf_(v[j]);
        }
        v4u o; o.x = pk2(v[0], v[1]); o.y = pk2(v[2], v[3]); o.z = pk2(v[4], v[5]); o.w = pk2(v[6], v[7]);
        *(LAS v4u*)(At + tk * AT_PITCH + c8) = o;
    }
    __syncthreads();
    const int l15 = lane & 15, l4 = lane >> 4;
    bf16x8 aW[2], aA[2], aG[4];
#pragma unroll
    for (int ks = 0; ks < 2; ++ks) { aW[ks] = *(const LAS bf16x8*)(At + l15 * AT_PITCH + ks * 32 + 8 * l4); aA[ks] = *(const LAS bf16x8*)(At + l15 * AT_PITCH + 64 + ks * 32 + 8 * l4); }
#pragma unroll
    for (int ks = 0; ks < 4; ++ks) aG[ks] = *(const LAS bf16x8*)(At + l15 * AT_PITCH + 128 + ks * 32 + 8 * l4);
    for (int hh = 0; hh < 2; ++hh) {
        const int h = wave * 2 + hh;
        float kkr[4][4], apv[4][4], rvv[4][4], ssq[4] = {0.f, 0.f, 0.f, 0.f}, bon[4] = {0.f, 0.f, 0.f, 0.f}, krs[4] = {0.f, 0.f, 0.f, 0.f}, brs[4] = {0.f, 0.f, 0.f, 0.f};
        bf16* sbase = F.STREAM + ((size_t)(bidx * 16 + h) * SEQ + tpos0) * ST_TOK;
#pragma unroll
        for (int nt = 0; nt < 4; ++nt) {
            const int c = h * 64 + nt * 16 + l15;
            f32x4 accW = (f32x4){0.f, 0.f, 0.f, 0.f}, accA = accW, accG = accW;
#pragma unroll
            for (int ks = 0; ks < 2; ++ks) {
                const bf16x8 bW = *(const bf16x8*)(F.WUP + (size_t)c * 64 + ks * 32 + 8 * l4);
                const bf16x8 bA = *(const bf16x8*)(F.AUP + (size_t)c * 64 + ks * 32 + 8 * l4);
                accW = __builtin_amdgcn_mfma_f32_16x16x32_bf16(aW[ks], bW, accW, 0, 0, 0);
                accA = __builtin_amdgcn_mfma_f32_16x16x32_bf16(aA[ks], bA, accA, 0, 0, 0);
            }
#pragma unroll
            for (int ks = 0; ks < 4; ++ks) {
                const bf16x8 bG = *(const bf16x8*)(F.GUP + (size_t)c * 128 + ks * 32 + 8 * l4);
                accG = __builtin_amdgcn_mfma_f32_16x16x32_bf16(aG[ks], bG, accG, 0, 0, 0);
            }
            const float mur = F.rw_mu[c], muk = F.rw_mu[1024 + c], muv = F.rw_mu[2048 + c];
            const float w0 = F.rw_w0[c], a0 = F.rw_a0[c], k_k = F.rw_k_k[c], k_a = F.rw_k_a[c], r_k = F.rw_r_k[c];
#pragma unroll
            for (int r = 0; r < 4; ++r) {
                const int tk = 4 * l4 + r;
                const bf16* zc = Z + (size_t)(row0 + tk) * INC + ZR + c;
                const bool first = (tpos0 + tk) == 0;
                float rc = bf2f(zc[0]), kc = bf2f(zc[1024]), vc = bf2f(zc[2048]);
                float rp = 0.f, kp = 0.f, vp = 0.f;
                if (!first) { rp = bf2f(zc[-INC]); kp = bf2f(zc[1024 - INC]); vp = bf2f(zc[2048 - INC]); }
                const float rv = rc + (rp - rc) * mur, kv = kc + (kp - kc) * muk, vv = vc + (vp - vc) * muv;
                const float sg = sigmoidf_(accW[r] + w0);
                const float dec = __expf(-0.6065306597126334f * sg), xw = 1.0f - dec;
                const float ap = sigmoidf_(accA[r] + a0);
                const float kr = kv * k_k;
                ssq[r] += kr * kr; kkr[nt][r] = kr; apv[nt][r] = ap; rvv[nt][r] = rv;
                const float kprime = kv * (1.0f + (ap - 1.0f) * k_a);
                bon[r] += rv * kprime * r_k; krs[r] += rv * kprime;
                bf16* sp = sbase + (size_t)tk * ST_TOK + nt * 16 + l15;
                sp[2 * (nt * 16 + l15) + 1 - (nt * 16 + l15)] = (bf16)f2bf(dec * rv);
                sp[192] = (bf16)f2bf(xw); sp[256] = (bf16)f2bf(kprime); sp[320] = (bf16)f2bf(vv); sp[384] = (bf16)f2bf(accG[r]);
            }
        }
#pragma unroll
        for (int r = 0; r < 4; ++r) { ssq[r] = reduce16(ssq[r]); bon[r] = reduce16(bon[r]); krs[r] = reduce16(krs[r]); }
#pragma unroll
        for (int r = 0; r < 4; ++r) {
            const int tk = 4 * l4 + r;
            const float inv = 1.0f / fmaxf(sqrtf(ssq[r]), 1e-12f);
#pragma unroll
            for (int nt = 0; nt < 4; ++nt) { const float kk = kkr[nt][r] * inv, bb = kk * apv[nt][r]; bf16* sp = sbase + (size_t)tk * ST_TOK + nt * 16 + l15;
                sp[nt * 16 + l15] = (bf16)f2bf(-kk); sp[128] = (bf16)f2bf(bb); brs[r] += bb * rvv[nt][r]; }
            const float br = reduce16(brs[r]);
            if (l15 == 0) *(f32x4*)(F.SC + ((size_t)(bidx * 16 + h) * SEQ + tpos0 + tk) * 4) = (f32x4){br, krs[r], bon[r], 0.f};
        }
    }
    __syncthreads();
}


namespace att {
constexpr int L_K = 0, L_V = 16384, L_WS = 32768, L_XB = 36864;
typedef short v4i16_t __attribute__((ext_vector_type(4)));
__device__ __forceinline__ int crow(int r, int hi) { return (r & 3) + 8 * (r >> 2) + 4 * hi; }
__device__ __forceinline__ unsigned cvtpk(float lo, float hi) { typedef float f2 __attribute__((ext_vector_type(2))); typedef __bf16 b2 __attribute__((ext_vector_type(2)));
    f2 v = {lo, hi}; b2 b = __builtin_convertvector(v, b2); return __builtin_bit_cast(unsigned, b); }
__device__ __forceinline__ s16x4 vtr(const LAS char* p) { return __builtin_bit_cast(s16x4, __builtin_amdgcn_ds_read_tr16_b64_v4i16((LAS v4i16_t*)p)); }

__device__ __forceinline__ void attn_item(const Frame& F, int b, int hv, int qb, float lam) {
    const int tid = F.tid, lane = F.lane, wid = F.wave, r32 = lane & 31, hi = lane >> 5;
    const int hsel = wid >> 2, wq = wid & 3, hq = 2 * hv + hsel;
    const int q0 = qb * 128 + wq * 32;
    const bf16* Zb = F.Z + (size_t)b * SEQ * INC;
    LAS char* shm = (LAS char*)F.lds;
    LAS float* wsf = (LAS float*)(shm + L_WS) + wid * 64;
    bf16x8 qr[4];
#pragma unroll
    for (int d0 = 0; d0 < 4; ++d0) qr[d0] = *(const bf16x8*)(Zb + (size_t)(q0 + r32) * INC + hq * 64 + d0 * 16 + hi * 8);
    const int NT = 2 * qb + 2;
    const bf16* ksrc = Zb + (size_t)lane * INC + ZK + hv * 128 + wid * 16;
    const bf16* vsrc0 = Zb + (size_t)(16 * ((2 * wid) & 3) + (lane >> 2)) * INC + ZV + hv * 128 + ((2 * wid) >> 2) * 32 + (lane & 3) * 8;
    const bf16* vsrc1 = Zb + (size_t)(16 * ((2 * wid + 1) & 3) + (lane >> 2)) * INC + ZV + hv * 128 + ((2 * wid + 1) >> 2) * 32 + (lane & 3) * 8;
    LAS char* kdst = shm + L_K + (2 * wid) * 1024 + lane * 16;
    LAS char* vdst = shm + L_V + (2 * wid) * 1024 + lane * 16;
    v4u kreg0, kreg1, vreg0, vreg1;
    kreg0 = *(const v4u*)(ksrc); kreg1 = *(const v4u*)(ksrc + 8); vreg0 = *(const v4u*)vsrc0; vreg1 = *(const v4u*)vsrc1;
    float m = -1e30f, l = 0.f;
    f32x16 o[4];
#pragma unroll
    for (int d = 0; d < 4; ++d) o[d] = (f32x16){};
    const LAS char* kp = shm + L_K + hsel * 8192 + hi * 1024 + r32 * 16;
    const LAS char* vp = shm + L_V + ((lane >> 4) & 1) * 32 + (lane & 3) * 8 + (4 * hi + ((lane & 15) >> 2)) * 64;
    for (int t = 0; t < NT; ++t) {
        __syncthreads();
        *(LAS v4u*)(kdst) = kreg0; *(LAS v4u*)(kdst + 1024) = kreg1; *(LAS v4u*)(vdst) = vreg0; *(LAS v4u*)(vdst + 1024) = vreg1;
        if (t + 1 < NT) { const size_t adv = (size_t)(t + 1) * 64 * INC;
            kreg0 = *(const v4u*)(ksrc + adv); kreg1 = *(const v4u*)(ksrc + adv + 8); vreg0 = *(const v4u*)(vsrc0 + adv); vreg1 = *(const v4u*)(vsrc1 + adv); }
        __syncthreads();
        if (t * 64 <= q0 + 31) {
            f32x16 p0 = (f32x16){}, p1 = (f32x16){};
#pragma unroll
            for (int d0 = 0; d0 < 4; ++d0) {
                const bf16x8 k0 = *(const LAS bf16x8*)(kp + d0 * 2048), k1 = *(const LAS bf16x8*)(kp + d0 * 2048 + 512);
                p0 = __builtin_amdgcn_mfma_f32_32x32x16_bf16(k0, qr[d0], p0, 0, 0, 0);
                p1 = __builtin_amdgcn_mfma_f32_32x32x16_bf16(k1, qr[d0], p1, 0, 0, 0);
            }
            if (t >= NT - 2) {
                const int qpos = q0 + r32, kb = t * 64 + 4 * hi;
#pragma unroll
                for (int r = 0; r < 16; ++r) { const int kv = kb + (r & 3) + 8 * (r >> 2); if (kv > qpos) p0[r] = -1e30f; if (kv + 32 > qpos) p1[r] = -1e30f; }
            }
            float mx = fmaxf(p0[0], p1[0]);
#pragma unroll
            for (int r = 1; r < 16; ++r) mx = fmaxf(mx, fmaxf(p0[r], p1[r]));
            { auto rr = __builtin_amdgcn_permlane32_swap(__builtin_bit_cast(unsigned, mx), __builtin_bit_cast(unsigned, mx), false, false);
              mx = fmaxf(__builtin_bit_cast(float, rr[0]), __builtin_bit_cast(float, rr[1])); }
            const float mn = fmaxf(m, mx), f = __builtin_amdgcn_exp2f(m - mn); m = mn;
            float ps = 0.f;
#pragma unroll
            for (int r = 0; r < 16; ++r) { p0[r] = __builtin_amdgcn_exp2f(p0[r] - mn); p1[r] = __builtin_amdgcn_exp2f(p1[r] - mn); ps += p0[r] + p1[r]; }
            l = l * f + ps;
            if (hi == 0) wsf[r32] = f;
            v4u pw0, pw1, pw2, pw3;
            pw0.x = cvtpk(p0[0], p0[1]); pw0.y = cvtpk(p0[2], p0[3]); pw0.z = cvtpk(p0[4], p0[5]); pw0.w = cvtpk(p0[6], p0[7]);
            pw1.x = cvtpk(p0[8], p0[9]); pw1.y = cvtpk(p0[10], p0[11]); pw1.z = cvtpk(p0[12], p0[13]); pw1.w = cvtpk(p0[14], p0[15]);
            pw2.x = cvtpk(p1[0], p1[1]); pw2.y = cvtpk(p1[2], p1[3]); pw2.z = cvtpk(p1[4], p1[5]); pw2.w = cvtpk(p1[6], p1[7]);
            pw3.x = cvtpk(p1[8], p1[9]); pw3.y = cvtpk(p1[10], p1[11]); pw3.z = cvtpk(p1[12], p1[13]); pw3.w = cvtpk(p1[14], p1[15]);
            {
                float fr[16];
#pragma unroll
                for (int r = 0; r < 16; ++r) fr[r] = wsf[crow(r, hi)];
#pragma unroll
                for (int d = 0; d < 4; ++d)
#pragma unroll
                    for (int r = 0; r < 16; ++r) o[d][r] *= fr[r];
            }
#pragma unroll
            for (int d = 0; d < 4; ++d) {
                s16x4 lo[4], hh[4];
#pragma unroll
                for (int ks = 0; ks < 4; ++ks) { lo[ks] = vtr(vp + d * 4096 + ks * 1024); hh[ks] = vtr(vp + d * 4096 + ks * 1024 + 512); }
#define ATT_VF(k) (bf16x8){lo[k][0], lo[k][1], lo[k][2], lo[k][3], hh[k][0], hh[k][1], hh[k][2], hh[k][3]}
                o[d] = __builtin_amdgcn_mfma_f32_32x32x16_bf16(__builtin_bit_cast(bf16x8, pw0), ATT_VF(0), o[d], 0, 0, 0);
                o[d] = __builtin_amdgcn_mfma_f32_32x32x16_bf16(__builtin_bit_cast(bf16x8, pw1), ATT_VF(1), o[d], 0, 0, 0);
                o[d] = __builtin_amdgcn_mfma_f32_32x32x16_bf16(__builtin_bit_cast(bf16x8, pw2), ATT_VF(2), o[d], 0, 0, 0);
                o[d] = __builtin_amdgcn_mfma_f32_32x32x16_bf16(__builtin_bit_cast(bf16x8, pw3), ATT_VF(3), o[d], 0, 0, 0);
#undef ATT_VF
            }
        }
    }
    { auto rr = __builtin_amdgcn_permlane32_swap(__builtin_bit_cast(unsigned, l), __builtin_bit_cast(unsigned, l), false, false);
      l = __builtin_bit_cast(float, rr[0]) + __builtin_bit_cast(float, rr[1]); }
    if (hi == 0) wsf[32 + r32] = (hsel ? lam : 1.0f) / l;
    {
        float rl[16];
#pragma unroll
        for (int r = 0; r < 16; ++r) rl[r] = wsf[32 + crow(r, hi)];
#pragma unroll
        for (int d = 0; d < 4; ++d)
#pragma unroll
            for (int r = 0; r < 16; ++r) o[d][r] *= rl[r];
    }
    LAS float* xb = (LAS float*)(shm + L_XB) + wq * 4096 + lane;
    if (hsel) {
#pragma unroll
        for (int d = 0; d < 4; ++d)
#pragma unroll
            for (int r = 0; r < 16; ++r) xb[(d * 16 + r) * 64] = o[d][r];
    }
    __syncthreads();
    if (!hsel) {
        float ss[16];
#pragma unroll
        for (int r = 0; r < 16; ++r) ss[r] = 0.f;
#pragma unroll
        for (int d = 0; d < 4; ++d)
#pragma unroll
            for (int r = 0; r < 16; ++r) { o[d][r] -= xb[(d * 16 + r) * 64]; ss[r] += o[d][r] * o[d][r]; }
        float sw[4];
#pragma unroll
        for (int d = 0; d < 4; ++d) sw[d] = F.subln_w[d * 32 + r32] * (1.0f - LAM_INIT);
#pragma unroll
        for (int r = 0; r < 16; ++r) {
            float s = reduce16(ss[r]); s += __shfl_xor(s, 16);
            const float rs = 1.0f / sqrtf(s * (1.0f / 128.0f) + 1e-5f);
            bf16* orow = F.MIX + (size_t)(b * SEQ + q0 + crow(r, hi)) * DM + hv * 128 + r32;
#pragma unroll
            for (int d = 0; d < 4; ++d) orow[d * 32] = (bf16)f2bf(o[d][r] * rs * sw[d]);
        }
    }
}
}


namespace scan {
constexpr int TP = 392, L_CB = 0, L_GB = 32 * TP * 4, L_YB = L_GB + 8192, CH = 32;
typedef float f2 __attribute__((ext_vector_type(2)));
__device__ __forceinline__ void reduce16x4(float& a, float& b, float& c, float& d) {
    asm volatile("s_nop 1\n\t"
        "v_add_f32_dpp %0, %0, %0 quad_perm:[1,0,3,2] row_mask:0xf bank_mask:0xf bound_ctrl:1\n\t"
        "v_add_f32_dpp %1, %1, %1 quad_perm:[1,0,3,2] row_mask:0xf bank_mask:0xf bound_ctrl:1\n\t"
        "v_add_f32_dpp %2, %2, %2 quad_perm:[1,0,3,2] row_mask:0xf bank_mask:0xf bound_ctrl:1\n\t"
        "v_add_f32_dpp %3, %3, %3 quad_perm:[1,0,3,2] row_mask:0xf bank_mask:0xf bound_ctrl:1\n\t"
        "v_add_f32_dpp %0, %0, %0 quad_perm:[2,3,0,1] row_mask:0xf bank_mask:0xf bound_ctrl:1\n\t"
        "v_add_f32_dpp %1, %1, %1 quad_perm:[2,3,0,1] row_mask:0xf bank_mask:0xf bound_ctrl:1\n\t"
        "v_add_f32_dpp %2, %2, %2 quad_perm:[2,3,0,1] row_mask:0xf bank_mask:0xf bound_ctrl:1\n\t"
        "v_add_f32_dpp %3, %3, %3 quad_perm:[2,3,0,1] row_mask:0xf bank_mask:0xf bound_ctrl:1\n\t"
        "v_add_f32_dpp %0, %0, %0 row_half_mirror row_mask:0xf bank_mask:0xf bound_ctrl:1\n\t"
        "v_add_f32_dpp %1, %1, %1 row_half_mirror row_mask:0xf bank_mask:0xf bound_ctrl:1\n\t"
        "v_add_f32_dpp %2, %2, %2 row_half_mirror row_mask:0xf bank_mask:0xf bound_ctrl:1\n\t"
        "v_add_f32_dpp %3, %3, %3 row_half_mirror row_mask:0xf bank_mask:0xf bound_ctrl:1\n\t"
        "v_add_f32_dpp %0, %0, %0 row_mirror row_mask:0xf bank_mask:0xf bound_ctrl:1\n\t"
        "v_add_f32_dpp %1, %1, %1 row_mirror row_mask:0xf bank_mask:0xf bound_ctrl:1\n\t"
        "v_add_f32_dpp %2, %2, %2 row_mirror row_mask:0xf bank_mask:0xf bound_ctrl:1\n\t"
        "v_add_f32_dpp %3, %3, %3 row_mirror row_mask:0xf bank_mask:0xf bound_ctrl:1\n\t"
        "s_nop 1"
        : "+v"(a), "+v"(b), "+v"(c), "+v"(d));
}
__device__ __forceinline__ void scan_item(const Frame& F, int bh) {
    const int tid = F.tid, p = tid >> 4, q = tid & 15;
    const int b = bh >> 4, h = bh & 15;
    LAS float* CB = (LAS float*)(F.lds + L_CB); LAS float* GB = (LAS float*)(F.lds + L_GB); LAS float* YB = (LAS float*)(F.lds + L_YB);
    const bf16* sbase = F.STREAM + (size_t)bh * SEQ * ST_TOK;
    const f32x4* scbase = (const f32x4*)F.SC + (size_t)bh * SEQ;
    f2 s[4];
#pragma unroll
    for (int j = 0; j < 4; ++j) s[j] = (f2){0.f, 0.f};
    v4u pf[4]; f32x4 scpf = (f32x4){0.f, 0.f, 0.f, 0.f};
#pragma unroll
    for (int i = 0; i < 4; ++i) { const int pid = tid + 512 * i; if (pid < 1792) pf[i] = *(const v4u*)(sbase + (size_t)pid * 8); }
    if (tid < CH) scpf = scbase[tid];
    const f32x4 lw = *(const f32x4*)(F.rw_lnx_w + h * 64 + 4 * q), lb = *(const f32x4*)(F.rw_lnx_b + h * 64 + 4 * q);
    for (int c = 0; c < SEQ / CH; ++c) {
        __syncthreads();
#pragma unroll
        for (int i = 0; i < 4; ++i) { const int pid = tid + 512 * i;
            if (pid < 1792) { const int tok = pid / 56, e8 = (pid - tok * 56) * 8;
                float v[8];
#pragma unroll
                for (int j = 0; j < 4; ++j) { v[2 * j] = bflo(pf[i][j]); v[2 * j + 1] = bfhi(pf[i][j]); }
                if (e8 >= 192 && e8 < 256) {
#pragma unroll
                    for (int j = 0; j < 8; ++j) v[j] = 1.0f - v[j];
                }
                LAS float* dst = (e8 < 384) ? (CB + tok * TP + e8) : (GB + tok * 64 + (e8 - 384));
                *(LAS f32x4*)dst = (f32x4){v[0], v[1], v[2], v[3]}; *(LAS f32x4*)(dst + 4) = (f32x4){v[4], v[5], v[6], v[7]}; } }
        if (tid < CH) *(LAS f32x4*)(CB + tid * TP + 384) = scpf;
        if (c + 1 < SEQ / CH) {
#pragma unroll
            for (int i = 0; i < 4; ++i) { const int pid = tid + 512 * i; if (pid < 1792) pf[i] = *(const v4u*)(sbase + (size_t)(c + 1) * CH * ST_TOK + (size_t)pid * 8); }
            if (tid < CH) scpf = scbase[(c + 1) * CH + tid];
        }
        __syncthreads();
#pragma unroll 4
        for (int tt = 0; tt < CH; ++tt) {
            const LAS float* cb = CB + tt * TP;
            const f32x4 aw0 = *(const LAS f32x4*)(cb + 8 * q), aw1 = *(const LAS f32x4*)(cb + 8 * q + 4);
            const f32x4 b4 = *(const LAS f32x4*)(cb + 128 + 4 * q), w4 = *(const LAS f32x4*)(cb + 192 + 4 * q), k4 = *(const LAS f32x4*)(cb + 256 + 4 * q);
            const f2 v2 = *(const LAS f2*)(cb + 320 + 2 * p), sc = *(const LAS f2*)(cb + 384);
            f2 acc0 = (f2){aw0[0], aw0[1]} * s[0].x, acc1 = (f2){aw0[0], aw0[1]} * s[0].y;
            acc0 += (f2){aw0[2], aw0[3]} * s[1].x; acc1 += (f2){aw0[2], aw0[3]} * s[1].y;
            acc0 += (f2){aw1[0], aw1[1]} * s[2].x; acc1 += (f2){aw1[0], aw1[1]} * s[2].y;
            acc0 += (f2){aw1[2], aw1[3]} * s[3].x; acc1 += (f2){aw1[2], aw1[3]} * s[3].y;
            float r0 = acc0.x, r1 = acc0.y, r2 = acc1.x, r3 = acc1.y;
            reduce16x4(r0, r1, r2, r3);
            const f2 sa = (f2){r0, r2};
            const f2 y = (f2){r1, r3} + sa * sc.x + v2 * sc.y;
#pragma unroll
            for (int j = 0; j < 4; ++j) s[j] = sa * b4[j] + (s[j] * w4[j] + v2 * k4[j]);
            if (q == 0) *(LAS f2*)(YB + tt * 64 + 2 * p) = y;
        }
        __syncthreads();
        {
            const f32x4 y4 = *(const LAS f32x4*)(YB + p * 64 + 4 * q);
            const float mean = reduce16((y4[0] + y4[1]) + (y4[2] + y4[3])) * (1.0f / 64.0f);
            const f32x4 d4 = y4 - mean;
            const float var = reduce16((d4[0] * d4[0] + d4[1] * d4[1]) + (d4[2] * d4[2] + d4[3] * d4[3])) * (1.0f / 64.0f);
            const float rs = 1.0f / sqrtf(var + 64e-5f);
            const f32x4 v4 = *(const LAS f32x4*)(CB + p * TP + 320 + 4 * q), g4 = *(const LAS f32x4*)(GB + p * 64 + 4 * q);
            const float bon = CB[p * TP + 386];
            f32x4 o = (d4 * rs * lw + lb + v4 * bon) * g4;
            v2u w; w.x = pk2(o[0], o[1]); w.y = pk2(o[2], o[3]);
            *(v2u*)(F.MIX + (size_t)(b * SEQ + c * CH + p) * DM + 1024 + h * 64 + 4 * q) = w;
        }
    }
}
}

__device__ __forceinline__ void p3_mix(const Frame& F, int qword) {
    float lam;
    { float d1 = 0.f, d2 = 0.f;
      for (int i = 0; i < 64; ++i) { d1 += F.lam_q1[i] * F.lam_k1[i]; d2 += F.lam_q2[i] * F.lam_k2[i]; }
      lam = __expf(d1) - __expf(d2) + LAM_INIT; }
    for (;;) {
        if (F.tid == 0) F.MISC[0] = atomicAdd(F.ctl + qword, 1u);
        __syncthreads();
        const int id = (int)__builtin_amdgcn_readfirstlane(F.MISC[0]);
        __syncthreads();
        if (id >= 64 + 1024 + N_MOE_QITEMS) break;
        if (id < 64) scan::scan_item(F, id);
        else if (id < 64 + 1024) { const int a = id - 64; const int qb = 31 - (a >> 5), bhv = a & 31; att::attn_item(F, bhv >> 3, bhv & 7, qb, lam); }
        else moe_convert_qitem(F, id - (64 + 1024));
    }
}


__device__ __forceinline__ void router_tile(const Frame& F, int tile, int cntw) {
    const int lane = F.lane, wid = F.wave, blk = wid & 3, kh = wid >> 2, l15 = lane & 15, l4 = lane >> 4;
    LAS float* xb = (LAS float*)F.lds;
    LAS float* lg = (LAS float*)(F.lds + 32768);
    const float* hrow = F.out + (size_t)(tile * 64 + blk * 16 + l15) * DM + kh * 1024 + 4 * l4;
    const float* wrow = F.WRT + (size_t)l15 * DM + kh * 1024 + 4 * l4;
    f32x4 acc[5];
#pragma unroll
    for (int nb = 0; nb < 5; ++nb) acc[nb] = (f32x4){0.f, 0.f, 0.f, 0.f};
    float ssq = 0.f;
#pragma unroll 2
    for (int s = 0; s < 64; ++s) {
        const f32x4 a = *(const f32x4*)(hrow + s * 16);
        f32x4 bq[5];
#pragma unroll
        for (int nb = 0; nb < 5; ++nb) bq[nb] = *(const f32x4*)(wrow + (size_t)nb * 16 * DM + s * 16);
        ssq += (a[0] * a[0] + a[1] * a[1]) + (a[2] * a[2] + a[3] * a[3]);
#pragma unroll
        for (int e = 0; e < 4; ++e)
#pragma unroll
            for (int nb = 0; nb < 5; ++nb) acc[nb] = __builtin_amdgcn_mfma_f32_16x16x4f32(a[e], bq[nb][e], acc[nb], 0, 0, 0);
    }
    ssq += __shfl_xor(ssq, 16); ssq += __shfl_xor(ssq, 32);
    __syncthreads();
    if (kh == 1) {
#pragma unroll
        for (int nb = 0; nb < 5; ++nb)
#pragma unroll
            for (int r = 0; r < 4; ++r) xb[(blk * 21 + nb * 4 + r) * 64 + lane] = acc[nb][r];
        xb[(blk * 21 + 20) * 64 + lane] = ssq;
    }
    __syncthreads();
    if (kh == 0) {
#pragma unroll
        for (int nb = 0; nb < 5; ++nb)
#pragma unroll
            for (int r = 0; r < 4; ++r) lg[(blk * 16 + 4 * l4 + r) * 81 + nb * 16 + l15] = acc[nb][r] + xb[(blk * 21 + nb * 4 + r) * 64 + lane];
        if (l4 == 0) lg[(blk * 16 + l15) * 81 + 80] = ssq + xb[(blk * 21 + 20) * 64 + lane];
    }
    __syncthreads();
    if (kh == 0 && lane < 16) {
        const int t = tile * 64 + blk * 16 + lane;
        const LAS float* L = lg + (blk * 16 + lane) * 81;
        const float r2 = 1.0f / sqrtf(L[80] * (1.0f / DM) + 1e-6f);
        float gl[8]; float gm = -3.0e38f; int gs = 0;
#pragma unroll
        for (int i = 0; i < 8; ++i) { gl[i] = L[i] * r2 + F.rg_b[i]; if (gl[i] > gm) { gm = gl[i]; gs = i; } }
        float gsum = 0.f;
#pragma unroll
        for (int i = 0; i < 8; ++i) gsum += __expf(gl[i] - gm);
        const float pg = 1.0f / gsum;
        float el[8]; float m0 = -3.0e38f, m1 = -3.0e38f; int i0 = 0, i1 = 0;
        #pragma unroll
        for (int i = 0; i < 8; ++i) { el[i] = L[8 + gs * 8 + i] * r2 + F.re_b[gs * 8 + i]; }
#pragma unroll
        for (int i = 0; i < 8; ++i) { if (el[i] > m0) { m1 = m0; i1 = i0; m0 = el[i]; i0 = i; } else if (el[i] > m1) { m1 = el[i]; i1 = i; } }
        const float e1 = __expf(m1 - m0);
        const float g0 = pg / (1.0f + e1), g1 = pg * e1 / (1.0f + e1);
        const int x0 = gs * 8 + i0, x1 = gs * 8 + i1;
        const int rk0 = (int)atomicAdd(F.ctl + cntw + x0, 1u), rk1 = (int)atomicAdd(F.ctl + cntw + x1, 1u);
        F.ROUTE_E[2 * t] = x0; F.ROUTE_E[2 * t + 1] = x1; F.ROUTE_R[2 * t] = rk0; F.ROUTE_R[2 * t + 1] = rk1;
        F.ROUTE_G[2 * t] = g0; F.ROUTE_G[2 * t + 1] = g1; F.R2[t] = r2;
    }
}
__device__ __forceinline__ void p6_gather(const Frame& F) {
    LAS int* tb = (LAS int*)F.lds;
    __syncthreads();
    if (F.tid == 0) { int acc = 0; for (int e = 0; e < NE; ++e) { tb[e] = acc; const int cnt = (int)__hip_atomic_load(F.ctl + CW_CNT + e, __ATOMIC_RELAXED, __HIP_MEMORY_SCOPE_AGENT); acc += (cnt + 255) >> 8; } tb[NE] = acc; }
    __syncthreads();
    if (blockIdx.x == 0) {
        if (F.tid < NE) { const int lo = tb[F.tid], hi = tb[F.tid + 1]; for (int i = lo; i < hi; ++i) F.TILEE[i] = F.tid; }
        if (F.tid == 0) F.ctl[CW_NT] = (unsigned)tb[NE];
    }
    const int gw = F.vcu * NWAVES + F.wave, NGW = F.G * NWAVES, lane = F.lane;
    f32x4 nw[8];
#pragma unroll
    for (int j = 0; j < 8; ++j) nw[j] = ((const f32x4*)F.norm2_w)[64 * j + lane];
    for (int t = gw; t < T; t += NGW) {
        const int e0 = F.ROUTE_E[2 * t], e1 = F.ROUTE_E[2 * t + 1];
        const int s0 = tb[e0] * 256 + F.ROUTE_R[2 * t], s1 = tb[e1] * 256 + F.ROUTE_R[2 * t + 1];
        const float r2 = F.R2[t];
        const f32x4* hr = (const f32x4*)(F.out + (size_t)t * DM) + lane;
        unsigned long long* o0 = (unsigned long long*)(F.XG + (size_t)s0 * DM) + lane;
        unsigned long long* o1 = (unsigned long long*)(F.XG + (size_t)s1 * DM) + lane;
#pragma unroll
        for (int j = 0; j < 8; ++j) { const f32x4 v = hr[64 * j] * r2 * nw[j];
            const unsigned long long w = (unsigned long long)pk2(v[0], v[1]) | ((unsigned long long)pk2(v[2], v[3]) << 32);
            o0[64 * j] = w; o1[64 * j] = w; }
        if (lane == 0) { F.SLOT[2 * t] = s0; F.SLOT[2 * t + 1] = s1; }
    }
}
__device__ __forceinline__ void p9_final(const Frame& F) {
    const int gw = F.vcu * NWAVES + F.wave, NGW = F.G * NWAVES, lane = F.lane;
    f32x4 fw[8];
#pragma unroll
    for (int j = 0; j < 8; ++j) fw[j] = ((const f32x4*)F.final_w)[64 * j + lane];
    for (int t = gw; t < T; t += NGW) {
        const int s0 = F.SLOT[2 * t], s1 = F.SLOT[2 * t + 1];
        const float g0 = F.ROUTE_G[2 * t], g1 = F.ROUTE_G[2 * t + 1];
        f32x4* hr = (f32x4*)(F.out + (size_t)t * DM) + lane;
        const v2u* y0 = (const v2u*)(F.Y + (size_t)s0 * DM) + lane;
        const v2u* y1 = (const v2u*)(F.Y + (size_t)s1 * DM) + lane;
        f32x4 v[8]; float ss = 0.f;
#pragma unroll
        for (int j = 0; j < 8; ++j) { const v2u a = y0[64 * j], c = y1[64 * j];
            const f32x4 ya = (f32x4){bflo(a.x), bfhi(a.x), bflo(a.y), bfhi(a.y)}, yc = (f32x4){bflo(c.x), bfhi(c.x), bflo(c.y), bfhi(c.y)};
            v[j] = hr[64 * j] + ya * g0 + yc * g1;
            ss += (v[j][0] * v[j][0] + v[j][1] * v[j][1]) + (v[j][2] * v[j][2] + v[j][3] * v[j][3]); }
        const float rs = 1.0f / sqrtf(wave_sum(ss) * (1.0f / DM) + 1e-6f);
#pragma unroll
        for (int j = 0; j < 8; ++j) hr[64 * j] = v[j] * rs * fw[j];
    }
}


struct Args { const float* in[29]; float* out; unsigned char* ws; int ph_lo, ph_hi; };
__global__ void __launch_bounds__(NTHR, 2) hybrid_fwd(Args args) {
    extern __shared__ __attribute__((aligned(16))) unsigned char lds[];
    Frame F;
    F.lds = (LAS unsigned char*)lds;
    F.MISC = (volatile LAS unsigned*)(F.lds + MISC_OFF);
    F.tid = threadIdx.x; F.lane = F.tid & 63; F.wave = __builtin_amdgcn_readfirstlane(F.tid >> 6);
    F.G = gridDim.x; { const int bx = blockIdx.x; F.vcu = (F.G % 8 == 0) ? (bx % 8) * (F.G / 8) + bx / 8 : bx; }
    unsigned char* ws = args.ws;
    F.ctl = (unsigned*)(ws + WS_CTL);
    F.x = args.in[0]; F.norm1_w = args.in[1]; F.w_in = args.in[2]; F.lam_q1 = args.in[3]; F.lam_k1 = args.in[4]; F.lam_q2 = args.in[5]; F.lam_k2 = args.in[6]; F.subln_w = args.in[7];
    F.rw_mu = args.in[8]; F.rw_w0 = args.in[9]; F.rw_w_up = args.in[10]; F.rw_a0 = args.in[11]; F.rw_a_up = args.in[12]; F.rw_g_up = args.in[13]; F.rw_k_k = args.in[14]; F.rw_k_a = args.in[15];
    F.rw_r_k = args.in[16]; F.rw_lnx_w = args.in[17]; F.rw_lnx_b = args.in[18]; F.w_out = args.in[19]; F.norm2_w = args.in[20]; F.rg_w = args.in[21]; F.rg_b = args.in[22]; F.re_w = args.in[23];
    F.re_b = args.in[24]; F.moe_w1 = args.in[25]; F.moe_w3 = args.in[26]; F.moe_w2 = args.in[27]; F.final_w = args.in[28];
    F.out = args.out;
    F.WIN = (bf16*)(ws + WS_WIN); F.WOUT = (bf16*)(ws + WS_WOUT); F.W13 = (bf16*)(ws + WS_W13); F.W2 = (bf16*)(ws + WS_W2);
    F.XN = (bf16*)(ws + WS_XN); F.MIX = (bf16*)(ws + WS_XN); F.Z = (bf16*)(ws + WS_Z); F.XG = (bf16*)(ws + WS_Z);
    F.STREAM = (bf16*)(ws + WS_STREAM); F.Y = (bf16*)(ws + WS_STREAM); F.HID = (bf16*)(ws + WS_HID);
    unsigned char* sm = ws + WS_SMALL;
    F.WUP = (bf16*)(sm + SM_WUP); F.AUP = (bf16*)(sm + SM_AUP); F.GUP = (bf16*)(sm + SM_GUP); F.WRT = (float*)(sm + SM_WRT); F.SC = (float*)(sm + SM_SC);
    F.ROUTE_E = (int*)(sm + SM_ROUTE_E); F.ROUTE_R = (int*)(sm + SM_ROUTE_R); F.ROUTE_G = (float*)(sm + SM_ROUTE_G); F.R2 = (float*)(sm + SM_R2); F.SLOT = (int*)(sm + SM_SLOT); F.TILEE = (int*)(sm + SM_TILEE);

    const int lo = args.ph_lo, hi = args.ph_hi;
    for (int u = F.tid; u < 64; u += NTHR) F.MISC[u] = 0u;
    __syncthreads();
    XcdBarrier bar; bar.bar = F.ctl + CW_BAR; bar.x = 0; bar.st = nullptr;
    if (hi - lo > 1) bar = xcd_barrier_post(F.ctl + CW_BAR, F.MISC + 8);
#define IN(k) (lo <= (k) && (k) < hi)
#define DUP(k) (DUP_PHASE == (k))
    unsigned long long st_t0 = 0, st_acc = 0; const bool st_me = (STALL_PHASE >= 0) && blockIdx.x == 0 && F.tid == 0;
#define TS(k) do { if (STALL_PHASE == (k) && st_me) st_t0 = __builtin_amdgcn_s_memrealtime(); } while (0)
#define TE(k) do { if (STALL_PHASE == (k) && st_me) st_acc += __builtin_amdgcn_s_memrealtime() - st_t0; } while (0)
#define SEAM(k) do { if (IN(k) && IN((k) + 1)) { if ((k) == 0) cg::this_grid().sync(); else xcd_barrier(bar); } } while (0)

    TS(0);
    if (IN(0)) { p0_prologue(F); if (DUP(0)) { __syncthreads(); p0_prologue(F); } SEAM(0); }
    TE(0);
    TS(1);
    if (IN(1)) {
        pg8::Gemm g{F.XN, F.WIN, T, INC, DM}; pg8::StaticOrder S; S.init(T, INC, F.G, (int)blockIdx.x);
        pg8::EpiBf16<0> E{F.Z, INC, nullptr, 0, 0, 1.0f};
        pg8::gemm_phase<pg8::EpiBf16<0>, pg8::StaticOrder, true, true>(F.lds, g, S, E);
        if (DUP(1)) { __syncthreads(); pg8::gemm_phase<pg8::EpiBf16<0>, pg8::StaticOrder, true, true>(F.lds, g, S, E); }
        SEAM(1);
    }
    TE(1);
    TS(2);
    if (IN(2)) { for (int u = F.vcu; u < T / 16; u += F.G) prep_unit(F, u, true); if (DUP(2)) { for (int u = F.vcu; u < T / 16; u += F.G) prep_unit(F, u, false); } SEAM(2); }
    TE(2);
    TS(3);
    if (IN(3)) { p3_mix(F, CW_QHEAD); if (DUP(3)) { p3_mix(F, CW_QHEAD + 1); } SEAM(3); }
    TE(3);
    TS(4);
    if (IN(4)) {
        pg8::Gemm g{F.MIX, F.WOUT, T, DM, DM}; pg8::StaticOrder S; S.init(T, DM, F.G, (int)blockIdx.x);
        pg8::EpiF32Res E{F.x, F.out, DM};
        pg8::gemm_phase<pg8::EpiF32Res, pg8::StaticOrder, true, true>(F.lds, g, S, E);
        if (DUP(4)) { __syncthreads(); pg8::gemm_phase<pg8::EpiF32Res, pg8::StaticOrder, true, true>(F.lds, g, S, E); }
        SEAM(4);
    }
    TE(4);
    TS(5);
    if (IN(5)) { for (int tl = F.vcu; tl < T / 64; tl += F.G) router_tile(F, tl, CW_CNT); if (DUP(5)) { for (int tl = F.vcu; tl < T / 64; tl += F.G) router_tile(F, tl, CW_CNT + 64); } SEAM(5); }
    TE(5);
    TS(6);
    if (IN(6)) { p6_gather(F); if (DUP(6)) { p6_gather(F); } SEAM(6); }
    TE(6);
    TS(7);
    if (IN(7)) {
        const int nT = __builtin_amdgcn_readfirstlane((int)__hip_atomic_load(F.ctl + CW_NT, __ATOMIC_RELAXED, __HIP_MEMORY_SCOPE_AGENT));
        pg8::Gemm g{F.XG, F.W13, PMAX, NE * 1024, DM}; pg8::MoeOrder S{F.TILEE, nT * 4, 4, F.G, (int)blockIdx.x};
        pg8::EpiSwiGLU E{F.HID};
        pg8::gemm_phase<pg8::EpiSwiGLU, pg8::MoeOrder, true, true>(F.lds, g, S, E);
        if (DUP(7)) { __syncthreads(); pg8::gemm_phase<pg8::EpiSwiGLU, pg8::MoeOrder, true, true>(F.lds, g, S, E); }
        SEAM(7);
    }
    TE(7);
    TS(8);
    if (IN(8)) {
        const int nT = __builtin_amdgcn_readfirstlane((int)__hip_atomic_load(F.ctl + CW_NT, __ATOMIC_RELAXED, __HIP_MEMORY_SCOPE_AGENT));
        pg8::Gemm g{F.HID, F.W2, PMAX, NE * 2048, DE}; pg8::MoeOrder S{F.TILEE, nT * 8, 8, F.G, (int)blockIdx.x};
        pg8::EpiBf16<0> E{F.Y, DM, nullptr, 2048, 0, 1.0f};
        pg8::gemm_phase<pg8::EpiBf16<0>, pg8::MoeOrder, true, true>(F.lds, g, S, E);
        if (DUP(8)) { __syncthreads(); pg8::gemm_phase<pg8::EpiBf16<0>, pg8::MoeOrder, true, true>(F.lds, g, S, E); }
        SEAM(8);
    }
    if (DUP(10)) { for (int i = 0; i < 10; ++i) xcd_barrier(bar); }
    TE(8);
    TS(9);
    if (IN(9)) { p9_final(F); }
    TE(9);
    if (st_me) { const unsigned long long t1 = __builtin_amdgcn_s_memrealtime(); while (__builtin_amdgcn_s_memrealtime() - t1 < st_acc) __builtin_amdgcn_s_sleep(8); }
#undef IN
#undef SEAM
}

extern "C" void kernel_launch(void* const* d_in, const int* in_sizes, int n_in, void* d_out, int out_size, void* d_ws, size_t ws_size, hipStream_t stream) {
    static int grid = 0;
    if (grid == 0) {
        if (n_in != 29 || in_sizes[0] != T * DM || out_size != T * DM || ws_size < WS_END) {
            fprintf(stderr, "kernel_launch: unexpected shapes (n_in %d, in0 %d, out %d, ws %zu; need ws >= %zu); nothing launched\n", n_in, n_in > 0 ? in_sizes[0] : -1, out_size, ws_size, (size_t)WS_END);
            grid = -1; return; }
        int dev = 0, cus = 0, per_cu = 0;
        if (hipGetDevice(&dev) != hipSuccess || hipDeviceGetAttribute(&cus, hipDeviceAttributeMultiprocessorCount, dev) != hipSuccess) { fprintf(stderr, "kernel_launch: device query failed\n"); grid = -1; return; }
        if (hipFuncSetAttribute((const void*)hybrid_fwd, hipFuncAttributeMaxDynamicSharedMemorySize, LDS_BYTES) != hipSuccess) { fprintf(stderr, "kernel_launch: hipFuncSetAttribute failed\n"); grid = -1; return; }
        if (hipOccupancyMaxActiveBlocksPerMultiprocessor(&per_cu, (const void*)hybrid_fwd, NTHR, LDS_BYTES) != hipSuccess || per_cu < 1) {
            fprintf(stderr, "kernel_launch: occupancy query reports %d blocks per CU\n", per_cu); (void)hipGetLastError(); per_cu = 1; }
        grid = cus;
        fprintf(stderr, "kernel_launch: grid %d (per_cu query %d), launches %d\n", grid, per_cu, N_LAUNCHES);
    }
    if (grid < 0) return;
    (void)hipMemsetAsync((char*)d_ws + WS_CTL, 0, CTL_ZERO_BYTES, stream);
    Args a{};
    for (int i = 0; i < 29; ++i) a.in[i] = (const float*)d_in[i];
    a.out = (float*)d_out; a.ws = (unsigned char*)d_ws;
    if (N_LAUNCHES == 1) {
        a.ph_lo = 0; a.ph_hi = NPHASE;
        void* kargs[] = {&a};
        hipError_t e = hipLaunchCooperativeKernel((const void*)hybrid_fwd, dim3(grid), dim3(NTHR), kargs, LDS_BYTES, stream);
        if (e != hipSuccess) fprintf(stderr, "kernel_launch: cooperative launch failed: %s (grid %d)\n", hipGetErrorString(e), grid);
    } else {
        for (int ph = 0; ph < NPHASE; ++ph) {
            a.ph_lo = ph; a.ph_hi = ph + 1;
            hipLaunchKernelGGL(hybrid_fwd, dim3(grid), dim3(NTHR), LDS_BYTES, stream, a);
            const hipError_t le = hipPeekAtLastError();
            if (le != hipSuccess) { fprintf(stderr, "kernel_launch: launch %d failed: %s\n", ph, hipGetErrorName(le)); break; }
        }
    }
}
```

```cpp
#include <hip/hip_runtime.h>
#include <hip/hip_cooperative_groups.h>
#include <cstdio>
#include <cstdint>
#include <cmath>
namespace cg = cooperative_groups;

#ifndef MK_N_LAUNCHES
#define MK_N_LAUNCHES 1
#endif

#ifndef DUP_PHASE
#define DUP_PHASE -1
#endif

#ifndef STALL_PHASE
#define STALL_PHASE -1
#endif

namespace pg8 {
#define PG8_LAS __attribute__((address_space(3)))
typedef unsigned short bf16_t;
typedef short bf16x8 __attribute__((ext_vector_type(8)));
typedef float f32x4 __attribute__((ext_vector_type(4)));
typedef unsigned u32x4 __attribute__((ext_vector_type(4)));
constexpr int BM = 256, BK = 64, HALF = 128, HTB = HALF * BK * 2  , STAGE_BYTES = 8 * HTB, NXCD = 8, WGM = 8;

__host__ __device__ __forceinline__ int lds_byte(int r, int c) { const int st = (r >> 4) * 2 + (c >> 5), rr = r & 15, cc = c & 31, ob = rr * 64 + cc * 2; return st * 1024 + (ob ^ (((ob >> 9) & 1) << 5)); }
__host__ __device__ __forceinline__ void stage_rc(int b, int& R, int& C) { const int st = b / 1024, sb = b % 1024, swz = sb ^ (((sb >> 9) & 1) << 5); R = (st >> 1) * 16 + swz / 64; C = (st & 1) * 32 + (swz % 64) / 2; }
__host__ __device__ __forceinline__ int perm32(int rho) { const int n = rho >> 4, i = rho & 15; return 8 * (i >> 2) + 4 * n + (i & 3); }

struct Unit { int pm, pn; };
struct Gemm { const bf16_t* A; const bf16_t* Bt; int M, N, K; };

struct StaticOrder {
    int nM, nN, nwg, G, c;
    __host__ __device__ void init(int M, int N, int G_, int c_) { nM = M / BM; nN = N / BM; nwg = nM * nN; G = G_; c = c_; }
    __host__ __device__ bool next(int i, Unit& u) const {
        const long L = (long)i * G + c; if (L >= nwg) return false;
        int wgid = (int)L; { const int q = nwg / NXCD, r = nwg % NXCD, xcd = wgid % NXCD, off = wgid / NXCD; wgid = (xcd < r ? xcd * (q + 1) : r * (q + 1) + (xcd - r) * q) + off; }
        const int nig = WGM * nN, gid = wgid / nig, fm = gid * WGM, gsz = (nM - fm) < WGM ? (nM - fm) : WGM;
        u.pm = fm + ((wgid % nig) % gsz); u.pn = (wgid % nig) / gsz; return true;
    }
    __device__ __forceinline__ void a_ready(const Unit&) const {}
    __device__ __forceinline__ void done(const Unit&) const {}
};

__device__ __forceinline__ unsigned cvt_pk_bf16(float lo, float hi) { unsigned r; asm volatile("v_cvt_pk_bf16_f32 %0, %1, %2" : "=v"(r) : "v"(lo), "v"(hi)); return r; }
typedef float f32x2 __attribute__((ext_vector_type(2)));
__device__ __forceinline__ f32x2 gelu_pk(f32x2 v) {
    const f32x2 av = __builtin_elementwise_abs(v), d = av * 0.2316418882f + 1.0f;
    f32x2 t; t.x = __builtin_amdgcn_rcpf(d.x); t.y = __builtin_amdgcn_rcpf(d.y);
    f32x2 q = t * 0.5307027145f + (-0.7265760135f); q = q * t + 0.7107068705f; q = q * t + (-0.142248368f); q = q * t + 0.127414796f; q = q * t;
    const f32x2 s = (v * v) * (-0.72134752044f);
    f32x2 e; e.x = __builtin_amdgcn_exp2f(s.x); e.y = __builtin_amdgcn_exp2f(s.y);
    const f32x2 m = v * (q * e), r = v - m;
    f32x2 o; o.x = v.x < 0.f ? m.x : r.x; o.y = v.y < 0.f ? m.y : r.y; return o;
}

template <int ACT  > struct EpiBf16 {
    static constexpr bool PERM = true, AFTER_DRAIN = false; static_assert(ACT == 0 || ACT == 1, "EpiBf16: ACT is 0 (none) or 1 (gelu_pk)");
    bf16_t* O; int ldc; const float* bias; int split_cols; size_t split_stride; float scale0;
    __device__ __forceinline__ void operator()(const f32x4 (&acc)[2][2][4][2], const Unit& u, int wr, int wc, int fr, int fq) const {
        const int row0 = u.pm * BM + wr * 64 + fr; int colt = u.pn * BM; bf16_t* base = O;
        float sc = 1.f; if (split_cols) { const int t = colt / split_cols; base += (size_t)t * split_stride; colt -= t * split_cols; if (t == 0) sc = scale0; }
        const int col0 = colt + wc * 32 + 8 * fq, bcol0 = u.pn * BM + wc * 32 + 8 * fq;
        f32x4 bv[2][2];
#pragma unroll
        for (int bj = 0; bj < 2; ++bj)
#pragma unroll
            for (int n = 0; n < 2; ++n) bv[bj][n] = bias ? *(const f32x4*)(bias + bcol0 + bj * HALF + 4 * n) : (f32x4){0.f, 0.f, 0.f, 0.f};
#pragma unroll
        for (int ai = 0; ai < 2; ++ai)
#pragma unroll
            for (int m = 0; m < 4; ++m) { bf16_t* rowp = base + (size_t)(row0 + ai * HALF + m * 16) * ldc + col0;
#pragma unroll
                for (int bj = 0; bj < 2; ++bj) { f32x4 v0 = acc[ai][bj][m][0] + bv[bj][0], v1 = acc[ai][bj][m][1] + bv[bj][1];
                    if (ACT == 1) { f32x2 a = gelu_pk((f32x2){v0[0], v0[1]}), b = gelu_pk((f32x2){v0[2], v0[3]}), c = gelu_pk((f32x2){v1[0], v1[1]}), d = gelu_pk((f32x2){v1[2], v1[3]});
                        v0 = (f32x4){a.x, a.y, b.x, b.y}; v1 = (f32x4){c.x, c.y, d.x, d.y}; }
                    v0 = v0 * sc; v1 = v1 * sc; u32x4 w; w.x = cvt_pk_bf16(v0[0], v0[1]); w.y = cvt_pk_bf16(v0[2], v0[3]); w.z = cvt_pk_bf16(v1[0], v1[1]); w.w = cvt_pk_bf16(v1[2], v1[3]);
                    *(u32x4*)(rowp + bj * HALF) = w; } }
    }
};

struct EpiF32Res {
    static constexpr bool PERM = false, AFTER_DRAIN = false;
    const float* base; float* out; int ldc;
    __device__ __forceinline__ void operator()(const f32x4 (&acc)[2][2][4][2], const Unit& u, int wr, int wc, int fr, int fq) const {
        const int row0 = u.pm * BM + wr * 64 + fr, col0 = u.pn * BM + wc * 32 + 4 * fq;
#pragma unroll
        for (int ai = 0; ai < 2; ++ai)
#pragma unroll
            for (int m = 0; m < 4; ++m) { const size_t off = (size_t)(row0 + ai * HALF + m * 16) * ldc + col0;
#pragma unroll
                for (int bj = 0; bj < 2; ++bj)
#pragma unroll
                    for (int n = 0; n < 2; ++n) { const f32x4 bs = *(const f32x4*)(base + off + bj * HALF + n * 16); *(f32x4*)(out + off + bj * HALF + n * 16) = bs + acc[ai][bj][m][n]; } }
    }
};
struct EpiSwiGLU {
    static constexpr bool PERM = true, AFTER_DRAIN = false;
    bf16_t* O;
    __device__ __forceinline__ void operator()(const f32x4 (&acc)[2][2][4][2], const Unit& u, int wr, int wc, int fr, int fq) const {
        const int row0 = u.pm * BM + wr * 64 + fr; const int col0 = (u.pn & 3) * HALF + wc * 32 + 8 * fq;
#pragma unroll
        for (int ai = 0; ai < 2; ++ai)
#pragma unroll
            for (int m = 0; m < 4; ++m) { bf16_t* rowp = O + (size_t)(row0 + ai * HALF + m * 16) * 512 + col0;
                float o[8];
#pragma unroll
                for (int n = 0; n < 2; ++n)
#pragma unroll
                    for (int i = 0; i < 4; ++i) { const float a = acc[ai][0][m][n][i], b = acc[ai][1][m][n][i]; o[n * 4 + i] = a * __builtin_amdgcn_rcpf(1.0f + __expf(-a)) * b; }
                u32x4 w; w.x = cvt_pk_bf16(o[0], o[1]); w.y = cvt_pk_bf16(o[2], o[3]); w.z = cvt_pk_bf16(o[4], o[5]); w.w = cvt_pk_bf16(o[6], o[7]);
                *(u32x4*)rowp = w; }
    }
};
struct MoeOrder {
    const int* tileE; int nunits, ncol, G, c;
    __device__ __forceinline__ bool next(int i, Unit& u) const {
        const int L = i * G + c; if (L >= nunits) return false;
        const int pm = L / ncol; const int e = __builtin_amdgcn_readfirstlane(tileE[pm]);
        u.pm = pm; u.pn = e * ncol + (L - pm * ncol); return true;
    }
    __device__ __forceinline__ void a_ready(const Unit&) const {}
    __device__ __forceinline__ void done(const Unit&) const {}
};

template <class Epi, class Sched, bool ALIGN_EPI = false, bool SP2 = false>
__device__ __forceinline__ void gemm_phase(PG8_LAS unsigned char* lds, const Gemm g, const Sched& S, const Epi& E) {
    const int tid = threadIdx.x, wid = __builtin_amdgcn_readfirstlane(tid >> 6), lane = tid & 63, wr = wid >> 2, wc = wid & 3, fr = lane & 15, fq = lane >> 4;
    const int K = g.K, nt = K / BK;
    unsigned voffA[2], voffB[2];
#pragma unroll
    for (int i = 0; i < 2; ++i) { int R, C; stage_rc(tid * 16 + i * 8192, R, C); const int Rb = Epi::PERM ? ((R & ~31) + perm32(R & 31)) : R;
        voffA[i] = (unsigned)(R * K + C) * 2u; voffB[i] = (unsigned)(Rb * K + C) * 2u; }
    const size_t kstep = (size_t)(BK * 2);
    const size_t hstep = (size_t)HALF * K * 2;
    const size_t tstep = 2 * hstep;
    const unsigned ldsw = (unsigned)wid * 1024u;
    const int aoff = lds_byte(wr * 64 + fr, fq * 8), boff = lds_byte(wc * 32 + fr, fq * 8);
#define PG8_SA(b, h) (((b) * 2 + (h)) * HTB)
#define PG8_SB(b, h) ((4 + (b) * 2 + (h)) * HTB)
#define PG8_STAGE(bufoff, gbase, voff) do { _Pragma("unroll") for (int _i = 0; _i < 2; ++_i) \
        __builtin_amdgcn_global_load_lds((const unsigned*)((const char*)(gbase) + (voff)[_i]), (PG8_LAS unsigned*)(lds + (bufoff) + ldsw + _i * 8192), 16, 0, 0); } while (0)
#define PG8_LDA(dst, b, h) do { _Pragma("unroll") for (int m = 0; m < 4; ++m) _Pragma("unroll") for (int k = 0; k < 2; ++k) dst[m][k] = *(const PG8_LAS bf16x8*)(lds + PG8_SA(b, h) + aoff + m * 2048 + k * 1024); } while (0)
#define PG8_LDB(dst, b, h) do { _Pragma("unroll") for (int n = 0; n < 2; ++n) _Pragma("unroll") for (int k = 0; k < 2; ++k) dst[n][k] = *(const PG8_LAS bf16x8*)(lds + PG8_SB(b, h) + boff + n * 2048 + k * 1024); } while (0)
#define PG8_MMA(ai, bj, At, Bt) do { __builtin_amdgcn_s_setprio(1); _Pragma("unroll") for (int m = 0; m < 4; ++m) _Pragma("unroll") for (int n = 0; n < 2; ++n) _Pragma("unroll") for (int k = 0; k < 2; ++k) \
        acc[ai][bj][m][n] = __builtin_amdgcn_mfma_f32_16x16x32_bf16(Bt[n][k], At[m][k], acc[ai][bj][m][n], 0, 0, 0); __builtin_amdgcn_s_setprio(0); } while (0)
#define PG8_WAIT_V(n) asm volatile("s_waitcnt vmcnt(" #n ")" ::: "memory")
#define PG8_WAIT_L(n) asm volatile("s_waitcnt lgkmcnt(" #n ")" ::: "memory")
#define PG8_BAR __builtin_amdgcn_s_barrier()
#define PG8_SCHED __builtin_amdgcn_sched_barrier(0)
    Unit cur, nxt; int ui = 0;
    if (!S.next(0, cur)) return;
    f32x4 acc[2][2][4][2];
#pragma unroll
    for (int a = 0; a < 2; ++a)
#pragma unroll
        for (int b = 0; b < 2; ++b)
#pragma unroll
            for (int m = 0; m < 4; ++m)
#pragma unroll
                for (int n = 0; n < 2; ++n) acc[a][b][m][n] = (f32x4){0.f, 0.f, 0.f, 0.f};
    bf16x8 At[4][2], B0[2][2], B1[2][2];
    const char* cA = (const char*)g.A + (size_t)cur.pm * tstep; const char* cB = (const char*)g.Bt + (size_t)cur.pn * tstep;
    S.a_ready(cur);
    if constexpr (SP2) {
        PG8_STAGE(PG8_SB(0, 0), cB, voffB); PG8_STAGE(PG8_SB(0, 1), cB + hstep, voffB); PG8_STAGE(PG8_SA(0, 0), cA, voffA); PG8_STAGE(PG8_SA(0, 1), cA + hstep, voffA);
        if (wr == 1) PG8_BAR;
        PG8_WAIT_V(2); PG8_BAR;
        PG8_STAGE(PG8_SB(1, 0), cB + kstep, voffB); PG8_STAGE(PG8_SA(1, 0), cA + kstep, voffA); PG8_STAGE(PG8_SB(1, 1), cB + hstep + kstep, voffB);
        PG8_WAIT_V(6); PG8_BAR;
    } else {
        PG8_STAGE(PG8_SB(0, 0), cB, voffB); PG8_STAGE(PG8_SA(0, 0), cA, voffA); PG8_STAGE(PG8_SB(0, 1), cB + hstep, voffB); PG8_STAGE(PG8_SA(0, 1), cA + hstep, voffA);
        if (wr == 1) PG8_BAR;
        PG8_WAIT_V(4); PG8_BAR;
        PG8_STAGE(PG8_SB(1, 0), cB + kstep, voffB); PG8_STAGE(PG8_SA(1, 0), cA + kstep, voffA); PG8_STAGE(PG8_SB(1, 1), cB + hstep + kstep, voffB);
        PG8_WAIT_V(6); PG8_BAR;
    }
    for (;;) {
        const bool has_next = S.next(ui + 1, nxt);
        const char* nA = has_next ? (const char*)g.A + (size_t)nxt.pm * tstep : cA; const char* nB = has_next ? (const char*)g.Bt + (size_t)nxt.pn * tstep : cB;
        for (int t = 0; t < nt; t += 2) {
            const bool last = (t == nt - 2);
            const char* a1 = cA + (size_t)(t + 1) * kstep;
            const char* a2 = last ? nA : cA + (size_t)(t + 2) * kstep; const char* b2 = last ? nB : cB + (size_t)(t + 2) * kstep;
            const char* a3 = a2 + kstep; const char* b3 = b2 + kstep;
            if (last && has_next) S.a_ready(nxt);
            if constexpr (SP2) {
            PG8_LDB(B0, 0, 0); PG8_LDB(B1, 0, 1); PG8_SCHED; PG8_LDA(At, 0, 0); PG8_STAGE(PG8_SA(1, 1), a1 + hstep, voffA);
            PG8_WAIT_V(8); PG8_WAIT_L(0); PG8_BAR; PG8_MMA(0, 0, At, B0); PG8_MMA(0, 1, At, B1); PG8_BAR; PG8_SCHED;
            PG8_LDA(At, 0, 1); PG8_STAGE(PG8_SB(0, 0), b2, voffB); PG8_STAGE(PG8_SB(0, 1), b2 + hstep, voffB); PG8_STAGE(PG8_SA(0, 0), a2, voffA);
            PG8_WAIT_V(8); PG8_WAIT_L(0); PG8_BAR; PG8_MMA(1, 0, At, B0); PG8_MMA(1, 1, At, B1); PG8_BAR; PG8_SCHED;
            PG8_LDB(B0, 1, 0); PG8_LDB(B1, 1, 1); PG8_SCHED; PG8_LDA(At, 1, 0); PG8_STAGE(PG8_SA(0, 1), a2 + hstep, voffA);
            PG8_WAIT_V(8); PG8_WAIT_L(0); PG8_BAR; PG8_MMA(0, 0, At, B0); PG8_MMA(0, 1, At, B1); PG8_BAR; PG8_SCHED;
            PG8_LDA(At, 1, 1); PG8_STAGE(PG8_SB(1, 0), b3, voffB); PG8_STAGE(PG8_SB(1, 1), b3 + hstep, voffB); PG8_STAGE(PG8_SA(1, 0), a3, voffA);
            PG8_WAIT_V(8); PG8_WAIT_L(0); PG8_BAR; PG8_MMA(1, 0, At, B0); PG8_MMA(1, 1, At, B1); PG8_BAR; PG8_SCHED;
            } else {
            PG8_LDB(B0, 0, 0); PG8_SCHED; PG8_LDA(At, 0, 0); PG8_STAGE(PG8_SA(1, 1), a1 + hstep, voffA);
            PG8_WAIT_L(8); PG8_BAR; PG8_WAIT_L(0); PG8_MMA(0, 0, At, B0); PG8_BAR; PG8_SCHED;
            PG8_LDB(B1, 0, 1); PG8_STAGE(PG8_SB(0, 0), b2, voffB);
            PG8_BAR; PG8_WAIT_L(0); PG8_MMA(0, 1, At, B1); PG8_BAR;
            PG8_LDA(At, 0, 1); PG8_STAGE(PG8_SA(0, 0), a2, voffA);
            PG8_BAR; PG8_WAIT_L(0); PG8_MMA(1, 0, At, B0); PG8_BAR; PG8_SCHED;
            PG8_STAGE(PG8_SB(0, 1), b2 + hstep, voffB);
            PG8_WAIT_V(6); PG8_BAR; PG8_MMA(1, 1, At, B1); PG8_BAR;
            PG8_LDB(B0, 1, 0); PG8_SCHED; PG8_LDA(At, 1, 0); PG8_STAGE(PG8_SA(0, 1), a2 + hstep, voffA);
            PG8_WAIT_L(8); PG8_BAR; PG8_WAIT_L(0); PG8_MMA(0, 0, At, B0); PG8_BAR; PG8_SCHED;
            PG8_LDB(B1, 1, 1); PG8_STAGE(PG8_SB(1, 0), b3, voffB);
            PG8_BAR; PG8_WAIT_L(0); PG8_MMA(0, 1, At, B1); PG8_BAR;
            PG8_LDA(At, 1, 1); PG8_STAGE(PG8_SA(1, 0), a3, voffA);
            PG8_BAR; PG8_WAIT_L(0); PG8_MMA(1, 0, At, B0); PG8_BAR; PG8_SCHED;
            PG8_STAGE(PG8_SB(1, 1), b3 + hstep, voffB);
            PG8_WAIT_V(6); PG8_BAR; PG8_MMA(1, 1, At, B1); PG8_BAR;
            }
        }
        if constexpr (ALIGN_EPI) { if (wr == 0) PG8_BAR; }
        if constexpr (!Epi::AFTER_DRAIN) { E(acc, cur, wr, wc, fr, fq); S.done(cur); }
        if (!has_next) break;
#pragma unroll
        for (int a = 0; a < 2; ++a)
#pragma unroll
            for (int b = 0; b < 2; ++b)
#pragma unroll
                for (int m = 0; m < 4; ++m)
#pragma unroll
                    for (int n = 0; n < 2; ++n) acc[a][b][m][n] = (f32x4){0.f, 0.f, 0.f, 0.f};
        cur = nxt; cA = nA; cB = nB; ++ui;
        if constexpr (ALIGN_EPI) { if (wr == 1) PG8_BAR; }
    }
    PG8_WAIT_V(0);
    if constexpr (!ALIGN_EPI) { if (wr == 0) PG8_BAR; }
    PG8_BAR;
    if constexpr (Epi::AFTER_DRAIN) { E.fused(acc, cur, wr, wc, fr, fq, lds, wid, lane); S.done(cur); }
#undef PG8_SA
#undef PG8_SB
#undef PG8_STAGE
#undef PG8_LDA
#undef PG8_LDB
#undef PG8_MMA
#undef PG8_WAIT_V
#undef PG8_WAIT_L
#undef PG8_BAR
#undef PG8_SCHED
}
}

constexpr int NWAVES = 8, NTHR = 512;
constexpr int BATCH = 4, SEQ = 4096, DM = 2048, T = BATCH * SEQ;
constexpr int INC = 6400;
constexpr int ZK = 1024, ZV = 2048, ZR = 3072;
constexpr int NE = 64, DE = 512;
constexpr int PMAX = 49152;
constexpr int NPHASE = 10;
constexpr int N_LAUNCHES = MK_N_LAUNCHES;
constexpr float C2 = 0.125f * 1.4426950408889634f;
constexpr float LAM_INIT = 0.2f;

constexpr size_t MiB = 1u << 20;
constexpr size_t WS_CTL = 0, CTL_ZERO_BYTES = 64 * 1024;
constexpr size_t WS_SMALL = 1 * MiB;
constexpr size_t WS_WIN = 9 * MiB;
constexpr size_t WS_WOUT = 34 * MiB;
constexpr size_t WS_W13 = 42 * MiB;
constexpr size_t WS_W2 = 298 * MiB;
constexpr size_t WS_XN = 426 * MiB;
constexpr size_t WS_Z = 490 * MiB;
constexpr size_t WS_STREAM = 690 * MiB;
constexpr size_t WS_HID = 914 * MiB;
constexpr size_t WS_END = 962 * MiB;
constexpr size_t SM_WUP = 0;
constexpr size_t SM_AUP = 128 * 1024;
constexpr size_t SM_GUP = 256 * 1024;
constexpr size_t SM_WRT = 512 * 1024;
constexpr size_t SM_ROUTE_E = 2 * MiB;
constexpr size_t SM_ROUTE_R = 2 * MiB + 128 * 1024;
constexpr size_t SM_ROUTE_G = 2 * MiB + 256 * 1024;
constexpr size_t SM_R2 = 2 * MiB + 384 * 1024;
constexpr size_t SM_SLOT = 2 * MiB + 512 * 1024;
constexpr size_t SM_TILEE = 3 * MiB;
constexpr size_t SM_SC = 3 * MiB + 64 * 1024;
constexpr int CW_QHEAD = 64;
constexpr int CW_NT = 128;
constexpr int CW_BAR = 4096;
constexpr int CW_CNT = 256;

constexpr int RING_BYTES = 131072;
constexpr int MISC_OFF = RING_BYTES;
constexpr int LDS_BYTES = 147456;

#define GAS __attribute__((address_space(1)))
#define LAS __attribute__((address_space(3)))
typedef unsigned short bf16;
typedef unsigned v4u __attribute__((ext_vector_type(4)));
typedef unsigned v2u __attribute__((ext_vector_type(2)));
typedef float f32x4 __attribute__((ext_vector_type(4)));
typedef float f32x16 __attribute__((ext_vector_type(16)));
typedef short bf16x8 __attribute__((ext_vector_type(8)));
typedef short s16x4 __attribute__((ext_vector_type(4)));

__device__ __forceinline__ unsigned f2bf(float f) { unsigned u = __builtin_bit_cast(unsigned, f); return (u + 0x7fffu + ((u >> 16) & 1u)) >> 16; }
__device__ __forceinline__ unsigned pk2(float lo, float hi) { return f2bf(lo) | (f2bf(hi) << 16); }
__device__ __forceinline__ float bf2f(unsigned b) { return __builtin_bit_cast(float, b << 16); }
__device__ __forceinline__ float bflo(unsigned w) { return __builtin_bit_cast(float, w << 16); }
__device__ __forceinline__ float bfhi(unsigned w) { return __builtin_bit_cast(float, w & 0xffff0000u); }
__device__ __forceinline__ float wave_sum(float v) {
#pragma unroll
    for (int o = 1; o < 64; o <<= 1) v += __shfl_xor(v, o);
    return v;
}
template <int CTRL> __device__ __forceinline__ float dpp_mov(float x) { return __builtin_bit_cast(float, __builtin_amdgcn_update_dpp(0, __builtin_bit_cast(int, x), CTRL, 0xF, 0xF, true)); }
__device__ __forceinline__ float reduce16(float x) {
    x += dpp_mov<0xB1>(x);
    x += dpp_mov<0x4E>(x);
    x += dpp_mov<0x141>(x);
    x += dpp_mov<0x140>(x);
    return x;
}
__device__ __forceinline__ float sigmoidf_(float x) { return __builtin_amdgcn_rcpf(1.0f + __expf(-x)); }

#define RLX_AGENT __ATOMIC_RELAXED, __HIP_MEMORY_SCOPE_AGENT
#define XB_TMO      128
#define XB_XCNT(j)  (256  + 64 * (j))
#define XB_XSUB(j)  (1280 + 64 * (j))
#define XB_XGEN(j)  (2304 + 64 * (j))
#define XB_TOP      3328
#define XB_TOPGEN   3392
#define XCD_BAR_WORDS 3456
#define XB_SPIN_CAP (1u << 18)

__device__ __forceinline__ unsigned xb_ld(unsigned* p)              { return __hip_atomic_load(p, __ATOMIC_RELAXED, __HIP_MEMORY_SCOPE_AGENT); }
__device__ __forceinline__ unsigned xb_add(unsigned* p, unsigned v) { return __hip_atomic_fetch_add(p, v, __ATOMIC_RELAXED, __HIP_MEMORY_SCOPE_AGENT); }
__device__ __forceinline__ unsigned xb_xcc_id() { return (unsigned)__builtin_amdgcn_s_getreg((3 << 11) | 20) & 0xFu; }
#define XB_SPIN(cond, bar) do { unsigned _sp = 0; while (cond) { __builtin_amdgcn_s_sleep(1); \
    if ((++_sp & 255u) == 0u) { if (xb_ld(&(bar)[XB_TMO])) break; if (_sp > XB_SPIN_CAP) { atomicAdd(&(bar)[XB_TMO], 1u); break; } } } } while (0)

struct XcdBarrier {
    unsigned* bar; unsigned x;
    volatile LAS unsigned* st;
};

__device__ __forceinline__ XcdBarrier xcd_barrier_post(unsigned* bar, volatile LAS unsigned* st) {
    XcdBarrier b; b.bar = bar; b.x = xb_xcc_id(); b.st = st;
    if (threadIdx.x == 0) (void)xb_add(&bar[XB_XCNT(b.x)], 1u);
    return b;
}
__device__ __forceinline__ void xcd_barrier_complete(unsigned* bar, unsigned x, unsigned& nloc, unsigned& nx) {
    const unsigned G = gridDim.x * gridDim.y * gridDim.z;
    unsigned sum, cnt, mine, sp = 0u;
    for (;;) {
        sum = 0u; cnt = 0u; mine = 0u;
#pragma unroll
        for (unsigned j = 0; j < 16; ++j) { const unsigned c = xb_ld(&bar[XB_XCNT(j)]); sum += c; cnt += (c > 0u) ? 1u : 0u; mine = (j == x) ? c : mine; }
        if (sum == G) break;
        __builtin_amdgcn_s_sleep(1);
        if ((++sp & 255u) == 0u) { if (xb_ld(&bar[XB_TMO])) break; if (sp > XB_SPIN_CAP) { atomicAdd(&bar[XB_TMO], 1u); break; } }
    }
    nloc = mine > 0u ? mine : 1u; nx = cnt > 0u ? cnt : 1u;
}

__device__ __forceinline__ void xcd_barrier(const XcdBarrier& b) {
    asm volatile("s_waitcnt vmcnt(0)" ::: "memory");
    __syncthreads();
    if (threadIdx.x == 0) {
        unsigned* bar = b.bar;
        __builtin_amdgcn_s_waitcnt(0);
        unsigned nloc = b.st[0], nx = b.st[1];
        if (nloc == 0u) { xcd_barrier_complete(bar, b.x, nloc, nx); b.st[0] = nloc; b.st[1] = nx; }
        const unsigned old = xb_add(&bar[XB_XSUB(b.x)], 1u);
        const unsigned gen = old / nloc;
        if (old + 1u == (gen + 1u) * nloc) {
            __builtin_amdgcn_fence(__ATOMIC_RELEASE, "agent");
            asm volatile("s_waitcnt vmcnt(0)" ::: "memory");
            const unsigned og = xb_add(&bar[XB_TOP], 1u);
            const unsigned tg = og / nx;
            if (og + 1u == (tg + 1u) * nx) xb_add(&bar[XB_TOPGEN], 1u);
            else XB_SPIN(xb_ld(&bar[XB_TOPGEN]) == tg, bar);
            __builtin_amdgcn_fence(__ATOMIC_ACQUIRE, "agent");
            xb_add(&bar[XB_XGEN(b.x)], 1u);
            asm volatile("s_waitcnt vmcnt(0)" ::: "memory");
        } else {
            XB_SPIN(xb_ld(&bar[XB_XGEN(b.x)]) == gen, bar);
            __builtin_amdgcn_fence(__ATOMIC_ACQUIRE, "agent");
            asm volatile("s_waitcnt vmcnt(0)" ::: "memory");
        }
    }
    __syncthreads();
}

struct Frame {
    LAS unsigned char* lds;
    volatile LAS unsigned* MISC;
    unsigned* ctl;
    int tid, lane, wave, vcu, G;
    const float *x, *norm1_w, *w_in, *lam_q1, *lam_k1, *lam_q2, *lam_k2, *subln_w, *rw_mu, *rw_w0, *rw_w_up, *rw_a0, *rw_a_up, *rw_g_up, *rw_k_k, *rw_k_a, *rw_r_k, *rw_lnx_w, *rw_lnx_b,
                *w_out, *norm2_w, *rg_w, *rg_b, *re_w, *re_b, *moe_w1, *moe_w3, *moe_w2, *final_w;
    float* out;
    bf16 *WIN, *WOUT, *W13, *W2, *XN, *MIX, *Z, *XG, *STREAM, *Y, *HID, *WUP, *AUP, *GUP;
    float *WRT, *SC, *ROUTE_G, *R2;
    int *ROUTE_E, *ROUTE_R, *SLOT, *TILEE;
};

__device__ __forceinline__ void p0_transpose_item(const float* W, int N, bf16* WT, int ldt, int dst_row0, int k0, int n0, const float* kscale, LAS float* scr, int lane) {
#pragma unroll 8
    for (int i = 0; i < 32; ++i) { const int kk = 2 * i + (lane >> 5); float v = W[(size_t)(k0 + kk) * N + n0 + (lane & 31)]; if (kscale) v *= kscale[k0 + kk]; scr[kk * 33 + (lane & 31)] = v; }
    asm volatile("s_waitcnt lgkmcnt(0)" ::: "memory");
    const int c = lane & 7;
#pragma unroll
    for (int j = 0; j < 4; ++j) { const int n = (lane >> 3) + 8 * j; const LAS float* s = scr + (8 * c) * 33 + n;
        v4u o; o.x = pk2(s[0 * 33], s[1 * 33]); o.y = pk2(s[2 * 33], s[3 * 33]); o.z = pk2(s[4 * 33], s[5 * 33]); o.w = pk2(s[6 * 33], s[7 * 33]);
        *(v4u*)(WT + (size_t)(dst_row0 + n) * ldt + k0 + 8 * c) = o; }
    asm volatile("s_waitcnt lgkmcnt(0)" ::: "memory");
}
constexpr int I_IN = 32 * 200, I_OUT = 32 * 64, I_W1 = 64 * 32 * 16, I_W2 = 64 * 8 * 64, I_UP = 32, I_GUP = 64;
constexpr int I_BASE = I_IN + I_OUT + 2 * I_UP + I_GUP, NITEMS = I_BASE + 2 * I_W1 + I_W2;
constexpr int MOE_WG_ITEMS = 256;
constexpr int N_MOE_QITEMS = (2 * I_W1 + I_W2) / MOE_WG_ITEMS;
__device__ __forceinline__ void convert_item(const Frame& F, int it, LAS float* scr, int lane) {
    int r = it;
    if (r < I_IN) { const int kb = r / 200, nb = r % 200; p0_transpose_item(F.w_in, INC, F.WIN, DM, 32 * nb, 64 * kb, 32 * nb, F.norm1_w, scr, lane); return; } r -= I_IN;
    if (r < I_OUT) { const int kb = r / 64, nb = r % 64; p0_transpose_item(F.w_out, DM, F.WOUT, DM, 32 * nb, 64 * kb, 32 * nb, nullptr, scr, lane); return; } r -= I_OUT;
    if (r < I_UP) { p0_transpose_item(F.rw_w_up, 1024, F.WUP, 64, 32 * r, 0, 32 * r, nullptr, scr, lane); return; } r -= I_UP;
    if (r < I_UP) { p0_transpose_item(F.rw_a_up, 1024, F.AUP, 64, 32 * r, 0, 32 * r, nullptr, scr, lane); return; } r -= I_UP;
    if (r < I_GUP) { const int kb = r / 32, nb = r % 32; p0_transpose_item(F.rw_g_up, 1024, F.GUP, 128, 32 * nb, 64 * kb, 32 * nb, nullptr, scr, lane); return; } r -= I_GUP;
    if (r < 2 * I_W1) { const int which = r / I_W1; r -= which * I_W1; const int e = r / 512, q = r % 512, kb = q / 16, nb = q % 16, n0 = 32 * nb;
        const float* W = (which ? F.moe_w3 : F.moe_w1) + (size_t)e * DM * DE;
        p0_transpose_item(W, DE, F.W13, DM, e * 1024 + (n0 >> 7) * 256 + which * 128 + (n0 & 127), 64 * kb, n0, nullptr, scr, lane); return; } r -= 2 * I_W1;
    { const int e = r / 512, q = r % 512, kb = q / 64, nb = q % 64;
      p0_transpose_item(F.moe_w2 + (size_t)e * DE * DM, DM, F.W2, DE, e * 2048 + 32 * nb, 64 * kb, 32 * nb, nullptr, scr, lane); }
}
__device__ __forceinline__ void moe_convert_qitem(const Frame& F, int qi) {
    LAS float* scr = (LAS float*)(F.lds + F.wave * 16384);
    const int base = I_BASE + qi * MOE_WG_ITEMS + F.wave * (MOE_WG_ITEMS / NWAVES);
    for (int i = 0; i < MOE_WG_ITEMS / NWAVES; ++i) convert_item(F, base + i, scr, F.lane);
}
__device__ __forceinline__ void p0_prologue(const Frame& F) {
    LAS float* scr = (LAS float*)(F.lds + F.wave * 16384);
    const int gw = F.vcu * NWAVES + F.wave, NGW = F.G * NWAVES, lane = F.lane;
    for (int it = gw; it < I_BASE; it += NGW) convert_item(F, it, scr, lane);
    for (int i = (F.vcu * NTHR + F.tid); i < 80 * DM; i += F.G * NTHR) { const int n = i / DM, k = i % DM;
        float v = 0.f; if (n < 8) v = F.rg_w[k * 8 + n]; else if (n < 72) v = F.re_w[k * 64 + (n - 8)];
        F.WRT[i] = v * F.norm2_w[k]; }
    for (int m = gw; m < T; m += NGW) {
        const f32x4* xr = (const f32x4*)(F.x + (size_t)m * DM) + lane;
        f32x4 v[8]; float s = 0.f;
#pragma unroll
        for (int j = 0; j < 8; ++j) { v[j] = xr[64 * j]; s += (v[j].x * v[j].x + v[j].y * v[j].y) + (v[j].z * v[j].z + v[j].w * v[j].w); }
        const float rs = 1.0f / sqrtf(wave_sum(s) * (1.0f / DM) + 1e-6f);
        unsigned long long* o8 = (unsigned long long*)(F.XN + (size_t)m * DM) + lane;
#pragma unroll
        for (int j = 0; j < 8; ++j) o8[64 * j] = (unsigned long long)pk2(v[j].x * rs, v[j].y * rs) | ((unsigned long long)pk2(v[j].z * rs, v[j].w * rs) << 32);
    }
}


constexpr int OPB = 13312;
constexpr int OP_W1T = 0, OP_QYT = 2048, OP_BLT = 4096, OP_HKT = 6144, OP_VT = 8192, OP_GT = 10240, OP_PYT = 12288, OP_LAM = 12800, OP_BON = 13056;
constexpr int AT_PITCH = 264;
constexpr int HT_PITCH = 72;
constexpr int PREP_WAVE_LDS = 12288;
__device__ __forceinline__ bf16x8 pack4z(float a, float b, float c, float d) { v4u o; o.x = pk2(a, b); o.y = pk2(c, d); o.z = 0u; o.w = 0u; return __builtin_bit_cast(bf16x8, o); }
__device__ __forceinline__ void prep_unit(const Frame& F, int unit, bool do_rope) {
    const int tid = F.tid, lane = F.lane, wave = F.wave;
    const int row0 = unit * 16, tpos0 = row0 & (SEQ - 1), bidx = row0 >> 12;
    bf16* Z = F.Z;
    if (do_rope) {
        const int tk = tid >> 5, i = tid & 31;
        const float pos = (float)(tpos0 + tk);
        const float inv = exp2f(-(float)i * (13.287712379549449f / 32.0f));
        const float ang = pos * inv;
        const float sn = sinf(ang), cs = cosf(ang);
        bf16* zr = Z + (size_t)(row0 + tk) * INC;
#pragma unroll 4
        for (int hh = 0; hh < 32; ++hh) {
            const int col = hh * 64 + i;
            const float x1 = bf2f(zr[col]), x2 = bf2f(zr[col + 32]);
            float o1 = x1 * cs - x2 * sn, o2 = x2 * cs + x1 * sn;
            if (hh < 16) { o1 *= C2; o2 *= C2; }
            zr[col] = (bf16)f2bf(o1); zr[col + 32] = (bf16)f2bf(o2);
        }
    }
    LAS bf16* At = (LAS bf16*)F.lds;
    {
        const int tk = tid >> 5, c8 = (tid & 31) * 8;
        const bool first = (tpos0 + tk) == 0;
        const bf16* zc = Z + (size_t)(row0 + tk) * INC + ZR + 3072 + c8;
        const v4u cur = *(const v4u*)zc;
        v4u prv = (v4u){0u, 0u, 0u, 0u}; if (!first) prv = *(const v4u*)(zc - INC);
        const f32x4 mu0 = *(const f32x4*)(F.rw_mu + 3072 + c8), mu1 = *(const f32x4*)(F.rw_mu + 3072 + c8 + 4);
        float v[8];
#pragma unroll
        for (int j = 0; j < 4; ++j) { const float c0 = bflo(cur[j]), c1 = bfhi(cur[j]), p0 = bflo(prv[j]), p1 = bfhi(prv[j]);
            const float m0 = (j < 2) ? mu0[2 * j] : mu1[2 * j - 4], m1 = (j < 2) ? mu0[2 * j + 1] : mu1[2 * j - 3];
            v[2 * j] = c0 + (p0 - c0) * m0; v[2 * j + 1] = c1 + (p1 - c1) * m1; }
        if (c8 < 64) {
#pragma unroll
            for (int j = 0; j < 8; ++j) { const float e = __expf(2.0f * v[j]); v[j] = 1.0f - 2.0f * __builtin_amdgcn_rcpf(e + 1.0f); }
        } else if (c8 >= 128) {
#pragma unroll
            for (int j = 0; j < 8; ++j) v[j] = sigmoidf_(v[j]);
        }
        v4u o; o.x = pk2(v[0], v[1]); o.y = pk2(v[2], v[3]); o.z = pk2(v[4], v[5]); o.w = pk2(v[6], v[7]);
        *(LAS v4u*)(At + tk * AT_PITCH + c8) = o;
    }
    __syncthreads();
    const int l15 = lane & 15, g = lane >> 4;
    LAS bf16* HT = (LAS bf16*)(F.lds + 16384 + wave * PREP_WAVE_LDS);
    LAS float* NL = (LAS float*)(F.lds + 16384 + wave * PREP_WAVE_LDS + 9216);
    for (int hh = 0; hh < 2; ++hh) {
        const int h = wave * 2 + hh;
        unsigned char* opb = (unsigned char*)F.STREAM + ((size_t)(bidx * 16 + h) * (SEQ / 16) + (tpos0 >> 4)) * OPB;
        float inv[4];
        {
            float ssq[4] = {0.f, 0.f, 0.f, 0.f};
#pragma unroll
            for (int nt = 0; nt < 4; ++nt) {
                const int c = h * 64 + nt * 16 + l15;
                const float muk = F.rw_mu[1024 + c], k_k = F.rw_k_k[c];
#pragma unroll
                for (int r = 0; r < 4; ++r) {
                    const int tk = 4 * g + r;
                    const bf16* zc = Z + (size_t)(row0 + tk) * INC + ZR + 1024 + c;
                    const float kc = bf2f(zc[0]); float kp = 0.f; if ((tpos0 + tk) != 0) kp = bf2f(zc[-INC]);
                    const float kr = (kc + (kp - kc) * muk) * k_k; ssq[r] += kr * kr;
                }
            }
#pragma unroll
            for (int r = 0; r < 4; ++r) inv[r] = 1.0f / fmaxf(sqrtf(reduce16(ssq[r])), 1e-12f);
        }
        float bon[4] = {0.f, 0.f, 0.f, 0.f}, lam15[4];
#pragma unroll
        for (int nt = 0; nt < 4; ++nt) {
            const int c = h * 64 + nt * 16 + l15;
            f32x4 accW = (f32x4){0.f, 0.f, 0.f, 0.f}, accA = accW, accG = accW;
            __builtin_amdgcn_sched_barrier(0);
            int aoff = l15 * AT_PITCH + 8 * g; asm volatile("" : "+v"(aoff));
#pragma unroll
            for (int ks = 0; ks < 2; ++ks) {
                const bf16x8 bW = *(const bf16x8*)(F.WUP + (size_t)c * 64 + ks * 32 + 8 * g);
                const bf16x8 bA = *(const bf16x8*)(F.AUP + (size_t)c * 64 + ks * 32 + 8 * g);
                accW = __builtin_amdgcn_mfma_f32_16x16x32_bf16(*(const LAS bf16x8*)(At + aoff + ks * 32), bW, accW, 0, 0, 0);
                accA = __builtin_amdgcn_mfma_f32_16x16x32_bf16(*(const LAS bf16x8*)(At + aoff + 64 + ks * 32), bA, accA, 0, 0, 0);
            }
#pragma unroll
            for (int ks = 0; ks < 4; ++ks) {
                const bf16x8 bG = *(const bf16x8*)(F.GUP + (size_t)c * 128 + ks * 32 + 8 * g);
                accG = __builtin_amdgcn_mfma_f32_16x16x32_bf16(*(const LAS bf16x8*)(At + aoff + 128 + ks * 32), bG, accG, 0, 0, 0);
            }
            const float mur = F.rw_mu[c], muk = F.rw_mu[1024 + c], muv = F.rw_mu[2048 + c];
            const float w0 = F.rw_w0[c], a0 = F.rw_a0[c], k_k = F.rw_k_k[c], k_a = F.rw_k_a[c], r_k = F.rw_r_k[c];
            float vv[4], dc[4], krv[4], apv[4], rvv[4], kpv[4];
#pragma unroll
            for (int r = 0; r < 4; ++r) {
                const int tk = 4 * g + r;
                const bf16* zc = Z + (size_t)(row0 + tk) * INC + ZR + c;
                const bool first = (tpos0 + tk) == 0;
                float rc = bf2f(zc[0]), kc = bf2f(zc[1024]), vc = bf2f(zc[2048]);
                float rp = 0.f, kp = 0.f, vp = 0.f;
                if (!first) { rp = bf2f(zc[-INC]); kp = bf2f(zc[1024 - INC]); vp = bf2f(zc[2048 - INC]); }
                const float rv = rc + (rp - rc) * mur, kv = kc + (kp - kc) * muk; vv[r] = vc + (vp - vc) * muv;
                const float sg = sigmoidf_(accW[r] + w0);
                dc[r] = __expf(-0.6065306597126334f * sg);
                const float ap = sigmoidf_(accA[r] + a0);
                krv[r] = kv * k_k * inv[r]; apv[r] = ap; rvv[r] = rv;
                const float kprime = kv * (1.0f + (ap - 1.0f) * k_a);
                kpv[r] = kprime;
                bon[r] += rv * kprime * r_k;
            }
            {
                const float p0 = dc[0], p1 = p0 * dc[1], p2 = p1 * dc[2], p3 = p2 * dc[3];
                const float G0 = __shfl(p3, l15), G1 = __shfl(p3, l15 + 16), G2 = __shfl(p3, l15 + 32), G3 = __shfl(p3, l15 + 48);
                const float pre = (g > 0 ? G0 : 1.0f) * (g > 1 ? G1 : 1.0f) * (g > 2 ? G2 : 1.0f);
                lam15[nt] = (G0 * G1) * (G2 * G3);
                const float L[4] = {pre * p0, pre * p1, pre * p2, pre * p3}, Lp[4] = {pre, pre * p0, pre * p1, pre * p2};
#pragma unroll
                for (int r = 0; r < 4; ++r) { const float il = __builtin_amdgcn_rcpf(L[r]);
                    LAS bf16* hp = HT + (4 * g + r) * HT_PITCH + nt * 16 + l15;
                    hp[0] = (bf16)f2bf(-krv[r] * Lp[r]);
                    hp[16 * HT_PITCH] = (bf16)f2bf(krv[r] * apv[r] * il);
                    hp[32 * HT_PITCH] = (bf16)f2bf(kpv[r] * il);
                    hp[48 * HT_PITCH] = (bf16)f2bf(rvv[r] * L[r]); }
                if (g == 0) *(float*)(opb + OP_LAM + (nt * 16 + l15) * 4) = lam15[nt];
            }
            { v2u w; w.x = pk2(vv[0], vv[1]); w.y = pk2(vv[2], vv[3]); *(v2u*)(opb + OP_VT + ((nt * 16 + l15) * 16 + 4 * g) * 2) = w;
              v2u u; u.x = pk2(accG[0], accG[1]); u.y = pk2(accG[2], accG[3]); *(v2u*)(opb + OP_GT + ((nt * 16 + l15) * 16 + 4 * g) * 2) = u; }
        }
#pragma unroll
        for (int r = 0; r < 4; ++r) bon[r] = reduce16(bon[r]);
        if (l15 == 0) *(f32x4*)(opb + OP_BON + 16 * g) = (f32x4){bon[0], bon[1], bon[2], bon[3]};
        __builtin_amdgcn_sched_barrier(0);
        f32x4 Nab = (f32x4){0.f, 0.f, 0.f, 0.f}, Nbr = Nab, NakT = Nab, NkrT = Nab;
#pragma unroll
        for (int s = 0; s < 2; ++s) {
            const bf16x8 fa = *(const LAS bf16x8*)(HT + l15 * HT_PITCH + 32 * s + 8 * g), fb = *(const LAS bf16x8*)(HT + (16 + l15) * HT_PITCH + 32 * s + 8 * g),
                         fk = *(const LAS bf16x8*)(HT + (32 + l15) * HT_PITCH + 32 * s + 8 * g), fr = *(const LAS bf16x8*)(HT + (48 + l15) * HT_PITCH + 32 * s + 8 * g);
            Nab = __builtin_amdgcn_mfma_f32_16x16x32_bf16(fb, fa, Nab, 0, 0, 0);
            Nbr = __builtin_amdgcn_mfma_f32_16x16x32_bf16(fb, fr, Nbr, 0, 0, 0);
            NakT = __builtin_amdgcn_mfma_f32_16x16x32_bf16(fa, fk, NakT, 0, 0, 0);
            NkrT = __builtin_amdgcn_mfma_f32_16x16x32_bf16(fr, fk, NkrT, 0, 0, 0);
        }
#pragma unroll
        for (int r = 0; r < 4; ++r) { const int row = 4 * g + r;
            if (!(row < l15)) Nab[r] = 0.f;
            if (!(row <= l15)) Nbr[r] = 0.f;
            if (!(l15 < row)) NakT[r] = 0.f;
            if (!(l15 <= row)) NkrT[r] = 0.f;
            NL[row * 16 + l15] = Nab[r]; }
        float Tc[16];
        Tc[15] = (l15 == 15) ? 1.0f : 0.0f;
#pragma unroll
        for (int s = 14; s >= 0; --s) {
            float val = (l15 == s) ? 1.0f : 0.0f;
#pragma unroll
            for (int p = s + 1; p < 16; ++p) val += NL[s * 16 + p] * Tc[p];
            Tc[s] = val;
        }
        float Tg[4];
#pragma unroll
        for (int r = 0; r < 4; ++r) Tg[r] = (g == 0) ? Tc[r] : (g == 1) ? Tc[4 + r] : (g == 2) ? Tc[8 + r] : Tc[12 + r];
        const bf16x8 fTt = pack4z(Tg[0], Tg[1], Tg[2], Tg[3]);
        const bf16x8 fNbrT = pack4z(Nbr[0], Nbr[1], Nbr[2], Nbr[3]);
        f32x4 W2T = __builtin_amdgcn_mfma_f32_16x16x32_bf16(fTt, pack4z(NakT[0], NakT[1], NakT[2], NakT[3]), (f32x4){0.f, 0.f, 0.f, 0.f}, 0, 0, 0);
        const bf16x8 fW2T = pack4z(W2T[0], W2T[1], W2T[2], W2T[3]);
        const f32x4 PyT = __builtin_amdgcn_mfma_f32_16x16x32_bf16(fNbrT, fW2T, NkrT, 0, 0, 0);
#pragma unroll
        for (int r = 0; r < 4; ++r) *(bf16*)(opb + OP_PYT + ((4 * g + r) * 16 + l15) * 2) = (bf16)f2bf(PyT[r]);
#pragma unroll
        for (int jt = 0; jt < 4; ++jt) {
            float ahv[4], bhv[4], khv[4], rhv[4];
#pragma unroll
            for (int r = 0; r < 4; ++r) { const LAS bf16* hp = HT + (4 * g + r) * HT_PITCH + jt * 16 + l15;
                ahv[r] = bf2f(hp[0]); bhv[r] = bf2f(hp[16 * HT_PITCH]); khv[r] = bf2f(hp[32 * HT_PITCH]); rhv[r] = bf2f(hp[48 * HT_PITCH]); }
            const f32x4 W1 = __builtin_amdgcn_mfma_f32_16x16x32_bf16(fTt, pack4z(ahv[0], ahv[1], ahv[2], ahv[3]), (f32x4){0.f, 0.f, 0.f, 0.f}, 0, 0, 0);
            const f32x4 Qy = __builtin_amdgcn_mfma_f32_16x16x32_bf16(fNbrT, pack4z(W1[0], W1[1], W1[2], W1[3]), (f32x4){rhv[0], rhv[1], rhv[2], rhv[3]}, 0, 0, 0);
            const f32x4 Hk = __builtin_amdgcn_mfma_f32_16x16x32_bf16(fW2T, pack4z(bhv[0], bhv[1], bhv[2], bhv[3]), (f32x4){khv[0], khv[1], khv[2], khv[3]}, 0, 0, 0);
            const int pos = 32 * (jt >> 1) + 8 * (l15 >> 2) + 4 * (jt & 1) + (l15 & 3);
#pragma unroll
            for (int r = 0; r < 4; ++r) { *(bf16*)(opb + OP_W1T + ((4 * g + r) * 64 + pos) * 2) = (bf16)f2bf(W1[r]); *(bf16*)(opb + OP_QYT + ((4 * g + r) * 64 + pos) * 2) = (bf16)f2bf(Qy[r]); }
            const float l15v = lam15[jt];
            v2u wb; wb.x = pk2(bhv[0] * l15v, bhv[1] * l15v); wb.y = pk2(bhv[2] * l15v, bhv[3] * l15v);
            *(v2u*)(opb + OP_BLT + ((jt * 16 + l15) * 16 + 4 * g) * 2) = wb;
            v2u wh; wh.x = pk2(Hk[0] * l15v, Hk[1] * l15v); wh.y = pk2(Hk[2] * l15v, Hk[3] * l15v);
            *(v2u*)(opb + OP_HKT + ((jt * 16 + l15) * 16 + 4 * g) * 2) = wh;
        }
    }
    __syncthreads();
}


namespace att {
constexpr int L_K = 0, L_V = 16384, L_WS = 32768, L_XB = 36864;
typedef short v4i16_t __attribute__((ext_vector_type(4)));
__device__ __forceinline__ int crow(int r, int hi) { return (r & 3) + 8 * (r >> 2) + 4 * hi; }
__device__ __forceinline__ unsigned cvtpk(float lo, float hi) { typedef float f2 __attribute__((ext_vector_type(2))); typedef __bf16 b2 __attribute__((ext_vector_type(2)));
    f2 v = {lo, hi}; b2 b = __builtin_convertvector(v, b2); return __builtin_bit_cast(unsigned, b); }
__device__ __forceinline__ s16x4 vtr(const LAS char* p) { return __builtin_bit_cast(s16x4, __builtin_amdgcn_ds_read_tr16_b64_v4i16((LAS v4i16_t*)p)); }

__device__ __forceinline__ void attn_item(const Frame& F, int b, int hv, int qb, float lam) {
    const int tid = F.tid, lane = F.lane, wid = F.wave, r32 = lane & 31, hi = lane >> 5;
    const int hsel = wid >> 2, wq = wid & 3, hq = 2 * hv + hsel;
    const int q0 = qb * 128 + wq * 32;
    const bf16* Zb = F.Z + (size_t)b * SEQ * INC;
    LAS char* shm = (LAS char*)F.lds;
    LAS float* wsf = (LAS float*)(shm + L_WS) + wid * 64;
    bf16x8 qr[4];
#pragma unroll
    for (int d0 = 0; d0 < 4; ++d0) qr[d0] = *(const bf16x8*)(Zb + (size_t)(q0 + r32) * INC + hq * 64 + d0 * 16 + hi * 8);
    const int NT = 2 * qb + 2;
    const bf16* ksrc = Zb + (size_t)lane * INC + ZK + hv * 128 + wid * 16;
    const bf16* vsrc0 = Zb + (size_t)(16 * ((2 * wid) & 3) + (lane >> 2)) * INC + ZV + hv * 128 + ((2 * wid) >> 2) * 32 + (lane & 3) * 8;
    const bf16* vsrc1 = Zb + (size_t)(16 * ((2 * wid + 1) & 3) + (lane >> 2)) * INC + ZV + hv * 128 + ((2 * wid + 1) >> 2) * 32 + (lane & 3) * 8;
    LAS char* kdst = shm + L_K + (2 * wid) * 1024 + lane * 16;
    LAS char* vdst = shm + L_V + (2 * wid) * 1024 + lane * 16;
    v4u kreg0, kreg1, vreg0, vreg1;
    kreg0 = *(const v4u*)(ksrc); kreg1 = *(const v4u*)(ksrc + 8); vreg0 = *(const v4u*)vsrc0; vreg1 = *(const v4u*)vsrc1;
    float m = -1e30f, l = 0.f;
    f32x16 o[4];
#pragma unroll
    for (int d = 0; d < 4; ++d) o[d] = (f32x16){};
    const LAS char* kp = shm + L_K + hsel * 8192 + hi * 1024 + r32 * 16;
    const LAS char* vp = shm + L_V + ((lane >> 4) & 1) * 32 + (lane & 3) * 8 + (4 * hi + ((lane & 15) >> 2)) * 64;
    for (int t = 0; t < NT; ++t) {
        __syncthreads();
        *(LAS v4u*)(kdst) = kreg0; *(LAS v4u*)(kdst + 1024) = kreg1; *(LAS v4u*)(vdst) = vreg0; *(LAS v4u*)(vdst + 1024) = vreg1;
        if (t + 1 < NT) { const size_t adv = (size_t)(t + 1) * 64 * INC;
            kreg0 = *(const v4u*)(ksrc + adv); kreg1 = *(const v4u*)(ksrc + adv + 8); vreg0 = *(const v4u*)(vsrc0 + adv); vreg1 = *(const v4u*)(vsrc1 + adv); }
        __syncthreads();
        if (t * 64 <= q0 + 31) {
            f32x16 p0 = (f32x16){}, p1 = (f32x16){};
#pragma unroll
            for (int d0 = 0; d0 < 4; ++d0) {
                const bf16x8 k0 = *(const LAS bf16x8*)(kp + d0 * 2048), k1 = *(const LAS bf16x8*)(kp + d0 * 2048 + 512);
                p0 = __builtin_amdgcn_mfma_f32_32x32x16_bf16(k0, qr[d0], p0, 0, 0, 0);
                p1 = __builtin_amdgcn_mfma_f32_32x32x16_bf16(k1, qr[d0], p1, 0, 0, 0);
            }
            if (t >= NT - 2) {
                const int qpos = q0 + r32, kb = t * 64 + 4 * hi;
#pragma unroll
                for (int r = 0; r < 16; ++r) { const int kv = kb + (r & 3) + 8 * (r >> 2); if (kv > qpos) p0[r] = -1e30f; if (kv + 32 > qpos) p1[r] = -1e30f; }
            }
            float mx = fmaxf(p0[0], p1[0]);
#pragma unroll
            for (int r = 1; r < 16; ++r) mx = fmaxf(mx, fmaxf(p0[r], p1[r]));
            { auto rr = __builtin_amdgcn_permlane32_swap(__builtin_bit_cast(unsigned, mx), __builtin_bit_cast(unsigned, mx), false, false);
              mx = fmaxf(__builtin_bit_cast(float, rr[0]), __builtin_bit_cast(float, rr[1])); }
            const float mn = fmaxf(m, mx), f = __builtin_amdgcn_exp2f(m - mn); m = mn;
            float ps = 0.f;
#pragma unroll
            for (int r = 0; r < 16; ++r) { p0[r] = __builtin_amdgcn_exp2f(p0[r] - mn); p1[r] = __builtin_amdgcn_exp2f(p1[r] - mn); ps += p0[r] + p1[r]; }
            l = l * f + ps;
            if (hi == 0) wsf[r32] = f;
            v4u pw0, pw1, pw2, pw3;
            pw0.x = cvtpk(p0[0], p0[1]); pw0.y = cvtpk(p0[2], p0[3]); pw0.z = cvtpk(p0[4], p0[5]); pw0.w = cvtpk(p0[6], p0[7]);
            pw1.x = cvtpk(p0[8], p0[9]); pw1.y = cvtpk(p0[10], p0[11]); pw1.z = cvtpk(p0[12], p0[13]); pw1.w = cvtpk(p0[14], p0[15]);
            pw2.x = cvtpk(p1[0], p1[1]); pw2.y = cvtpk(p1[2], p1[3]); pw2.z = cvtpk(p1[4], p1[5]); pw2.w = cvtpk(p1[6], p1[7]);
            pw3.x = cvtpk(p1[8], p1[9]); pw3.y = cvtpk(p1[10], p1[11]); pw3.z = cvtpk(p1[12], p1[13]); pw3.w = cvtpk(p1[14], p1[15]);
            {
                float fr[16];
#pragma unroll
                for (int r = 0; r < 16; ++r) fr[r] = wsf[crow(r, hi)];
#pragma unroll
                for (int d = 0; d < 4; ++d)
#pragma unroll
                    for (int r = 0; r < 16; ++r) o[d][r] *= fr[r];
            }
#pragma unroll
            for (int d = 0; d < 4; ++d) {
                s16x4 lo[4], hh[4];
#pragma unroll
                for (int ks = 0; ks < 4; ++ks) { lo[ks] = vtr(vp + d * 4096 + ks * 1024); hh[ks] = vtr(vp + d * 4096 + ks * 1024 + 512); }
#define ATT_VF(k) (bf16x8){lo[k][0], lo[k][1], lo[k][2], lo[k][3], hh[k][0], hh[k][1], hh[k][2], hh[k][3]}
                o[d] = __builtin_amdgcn_mfma_f32_32x32x16_bf16(__builtin_bit_cast(bf16x8, pw0), ATT_VF(0), o[d], 0, 0, 0);
                o[d] = __builtin_amdgcn_mfma_f32_32x32x16_bf16(__builtin_bit_cast(bf16x8, pw1), ATT_VF(1), o[d], 0, 0, 0);
                o[d] = __builtin_amdgcn_mfma_f32_32x32x16_bf16(__builtin_bit_cast(bf16x8, pw2), ATT_VF(2), o[d], 0, 0, 0);
                o[d] = __builtin_amdgcn_mfma_f32_32x32x16_bf16(__builtin_bit_cast(bf16x8, pw3), ATT_VF(3), o[d], 0, 0, 0);
#undef ATT_VF
            }
        }
    }
    { auto rr = __builtin_amdgcn_permlane32_swap(__builtin_bit_cast(unsigned, l), __builtin_bit_cast(unsigned, l), false, false);
      l = __builtin_bit_cast(float, rr[0]) + __builtin_bit_cast(float, rr[1]); }
    if (hi == 0) wsf[32 + r32] = (hsel ? lam : 1.0f) / l;
    {
        float rl[16];
#pragma unroll
        for (int r = 0; r < 16; ++r) rl[r] = wsf[32 + crow(r, hi)];
#pragma unroll
        for (int d = 0; d < 4; ++d)
#pragma unroll
            for (int r = 0; r < 16; ++r) o[d][r] *= rl[r];
    }
    LAS float* xb = (LAS float*)(shm + L_XB) + wq * 4096 + lane;
    if (hsel) {
#pragma unroll
        for (int d = 0; d < 4; ++d)
#pragma unroll
            for (int r = 0; r < 16; ++r) xb[(d * 16 + r) * 64] = o[d][r];
    }
    __syncthreads();
    if (!hsel) {
        float ss[16];
#pragma unroll
        for (int r = 0; r < 16; ++r) ss[r] = 0.f;
#pragma unroll
        for (int d = 0; d < 4; ++d)
#pragma unroll
            for (int r = 0; r < 16; ++r) { o[d][r] -= xb[(d * 16 + r) * 64]; ss[r] += o[d][r] * o[d][r]; }
        float sw[4];
#pragma unroll
        for (int d = 0; d < 4; ++d) sw[d] = F.subln_w[d * 32 + r32] * (1.0f - LAM_INIT);
#pragma unroll
        for (int r = 0; r < 16; ++r) {
            float s = reduce16(ss[r]); s += __shfl_xor(s, 16);
            const float rs = 1.0f / sqrtf(s * (1.0f / 128.0f) + 1e-5f);
            bf16* orow = F.MIX + (size_t)(b * SEQ + q0 + crow(r, hi)) * DM + hv * 128 + r32;
#pragma unroll
            for (int d = 0; d < 4; ++d) orow[d * 32] = (bf16)f2bf(o[d][r] * rs * sw[d]);
        }
    }
}
}


namespace scan {
struct Ops { bf16x8 w1a[2], qya[2]; v2u pya, vtb, gtb, bla[4], hka[4]; f32x4 lam[4], bon; };
__device__ __forceinline__ void load_ops(Ops& o, const unsigned char* opb, int i0, int l15, int g) {
#pragma unroll
    for (int s = 0; s < 2; ++s) { o.w1a[s] = *(const bf16x8*)(opb + OP_W1T + (l15 * 64 + 32 * s + 8 * g) * 2); o.qya[s] = *(const bf16x8*)(opb + OP_QYT + (l15 * 64 + 32 * s + 8 * g) * 2); }
    o.pya = *(const v2u*)(opb + OP_PYT + (l15 * 16 + 4 * g) * 2);
    o.vtb = *(const v2u*)(opb + OP_VT + ((i0 + l15) * 16 + 4 * g) * 2);
    o.gtb = *(const v2u*)(opb + OP_GT + ((i0 + l15) * 16 + 4 * g) * 2);
#pragma unroll
    for (int jt = 0; jt < 4; ++jt) { o.bla[jt] = *(const v2u*)(opb + OP_BLT + ((jt * 16 + l15) * 16 + 4 * g) * 2); o.hka[jt] = *(const v2u*)(opb + OP_HKT + ((jt * 16 + l15) * 16 + 4 * g) * 2);
        o.lam[jt] = *(const f32x4*)(opb + OP_LAM + (jt * 16 + 4 * g) * 4); }
    o.bon = *(const f32x4*)(opb + OP_BON + 16 * g);
}
__device__ __forceinline__ bf16x8 padz(v2u x) { v4u o; o.x = x.x; o.y = x.y; o.z = 0u; o.w = 0u; return __builtin_bit_cast(bf16x8, o); }
__device__ __forceinline__ void apply_item(const Frame& F, int item) {
    const int lane = F.lane, wid = F.wave, l15 = lane & 15, g = lane >> 4;
    const int sel = wid >> 2, iw = wid & 3, i0 = 16 * iw;
    const int bh = 2 * item + sel, b = bh >> 4, h = bh & 15;
    LAS float* stat = (LAS float*)F.lds;
    const unsigned char* ops = (const unsigned char*)F.STREAM + (size_t)bh * (SEQ / 16) * OPB;
    f32x4 St[4];
#pragma unroll
    for (int jt = 0; jt < 4; ++jt) St[jt] = (f32x4){0.f, 0.f, 0.f, 0.f};
    const float lw = F.rw_lnx_w[h * 64 + i0 + l15], lb = F.rw_lnx_b[h * 64 + i0 + l15];
    Ops cur, nxt;
    load_ops(cur, ops, i0, l15, g);
    for (int c = 0; c < SEQ / 16; ++c) {
        if (c + 1 < SEQ / 16) load_ops(nxt, ops + (size_t)(c + 1) * OPB, i0, l15, g);
        bf16x8 sb[2];
#pragma unroll
        for (int s = 0; s < 2; ++s) { v4u o; o.x = pk2(St[2 * s][0], St[2 * s][1]); o.y = pk2(St[2 * s][2], St[2 * s][3]); o.z = pk2(St[2 * s + 1][0], St[2 * s + 1][1]); o.w = pk2(St[2 * s + 1][2], St[2 * s + 1][3]);
            sb[s] = __builtin_bit_cast(bf16x8, o); }
        f32x4 X1 = __builtin_amdgcn_mfma_f32_16x16x32_bf16(cur.w1a[0], sb[0], (f32x4){0.f, 0.f, 0.f, 0.f}, 0, 0, 0);
        f32x4 Y = __builtin_amdgcn_mfma_f32_16x16x32_bf16(cur.qya[0], sb[0], (f32x4){0.f, 0.f, 0.f, 0.f}, 0, 0, 0);
        X1 = __builtin_amdgcn_mfma_f32_16x16x32_bf16(cur.w1a[1], sb[1], X1, 0, 0, 0);
        Y = __builtin_amdgcn_mfma_f32_16x16x32_bf16(cur.qya[1], sb[1], Y, 0, 0, 0);
        const bf16x8 vb = padz(cur.vtb);
        Y = __builtin_amdgcn_mfma_f32_16x16x32_bf16(padz(cur.pya), vb, Y, 0, 0, 0);
        const bf16x8 xb = pack4z(X1[0], X1[1], X1[2], X1[3]);
#pragma unroll
        for (int jt = 0; jt < 4; ++jt) {
            St[jt] = St[jt] * cur.lam[jt];
            St[jt] = __builtin_amdgcn_mfma_f32_16x16x32_bf16(padz(cur.bla[jt]), xb, St[jt], 0, 0, 0);
            St[jt] = __builtin_amdgcn_mfma_f32_16x16x32_bf16(padz(cur.hka[jt]), vb, St[jt], 0, 0, 0);
        }
        float s1[4], s2[4];
#pragma unroll
        for (int r = 0; r < 4; ++r) { s1[r] = reduce16(Y[r]); s2[r] = reduce16(Y[r] * Y[r]); }
        LAS float* st = stat + ((c & 1) * 2 + sel) * 128;
        if (l15 == 0) {
#pragma unroll
            for (int r = 0; r < 4; ++r) { st[(iw * 16 + 4 * g + r) * 2] = s1[r]; st[(iw * 16 + 4 * g + r) * 2 + 1] = s2[r]; }
        }
        __syncthreads();
        const float vvv[4] = {bflo(cur.vtb.x), bfhi(cur.vtb.x), bflo(cur.vtb.y), bfhi(cur.vtb.y)};
        const float ggg[4] = {bflo(cur.gtb.x), bfhi(cur.gtb.x), bflo(cur.gtb.y), bfhi(cur.gtb.y)};
#pragma unroll
        for (int r = 0; r < 4; ++r) {
            float a1 = 0.f, a2 = 0.f;
#pragma unroll
            for (int w = 0; w < 4; ++w) { a1 += st[(w * 16 + 4 * g + r) * 2]; a2 += st[(w * 16 + 4 * g + r) * 2 + 1]; }
            const float mean = a1 * (1.0f / 64.0f), var = fmaxf(a2 * (1.0f / 64.0f) - mean * mean, 0.f);
            const float rs = 1.0f / sqrtf(var + 64e-5f);
            const float o = ((Y[r] - mean) * rs * lw + lb + cur.bon[r] * vvv[r]) * ggg[r];
            F.MIX[(size_t)(b * SEQ + c * 16 + 4 * g + r) * DM + 1024 + h * 64 + i0 + l15] = (bf16)f2bf(o);
        }
        cur = nxt;
    }
}
}

__device__ __forceinline__ void p3_mix(const Frame& F, int qword) {
    float lam;
    { float d1 = 0.f, d2 = 0.f;
      for (int i = 0; i < 64; ++i) { d1 += F.lam_q1[i] * F.lam_k1[i]; d2 += F.lam_q2[i] * F.lam_k2[i]; }
      lam = __expf(d1) - __expf(d2) + LAM_INIT; }
    for (;;) {
        if (F.tid == 0) F.MISC[0] = atomicAdd(F.ctl + qword, 1u);
        __syncthreads();
        const int id = (int)__builtin_amdgcn_readfirstlane(F.MISC[0]);
        __syncthreads();
        if (id >= 32 + 1024 + N_MOE_QITEMS) break;
        if (id < 32) scan::apply_item(F, id);
        else if (id < 32 + 1024) { const int a = id - 32; const int qb = 31 - (a >> 5), bhv = a & 31; att::attn_item(F, bhv >> 3, bhv & 7, qb, lam); }
        else moe_convert_qitem(F, id - (32 + 1024));
    }
}


__device__ __forceinline__ void router_tile(const Frame& F, int tile, int cntw) {
    const int lane = F.lane, wid = F.wave, blk = wid & 3, kh = wid >> 2, l15 = lane & 15, l4 = lane >> 4;
    LAS float* xb = (LAS float*)F.lds;
    LAS float* lg = (LAS float*)(F.lds + 32768);
    const float* hrow = F.out + (size_t)(tile * 64 + blk * 16 + l15) * DM + kh * 1024 + 4 * l4;
    const float* wrow = F.WRT + (size_t)l15 * DM + kh * 1024 + 4 * l4;
    f32x4 acc[5];
#pragma unroll
    for (int nb = 0; nb < 5; ++nb) acc[nb] = (f32x4){0.f, 0.f, 0.f, 0.f};
    float ssq = 0.f;
#pragma unroll 2
    for (int s = 0; s < 64; ++s) {
        const f32x4 a = *(const f32x4*)(hrow + s * 16);
        f32x4 bq[5];
#pragma unroll
        for (int nb = 0; nb < 5; ++nb) bq[nb] = *(const f32x4*)(wrow + (size_t)nb * 16 * DM + s * 16);
        ssq += (a[0] * a[0] + a[1] * a[1]) + (a[2] * a[2] + a[3] * a[3]);
#pragma unroll
        for (int e = 0; e < 4; ++e)
#pragma unroll
            for (int nb = 0; nb < 5; ++nb) acc[nb] = __builtin_amdgcn_mfma_f32_16x16x4f32(a[e], bq[nb][e], acc[nb], 0, 0, 0);
    }
    ssq += __shfl_xor(ssq, 16); ssq += __shfl_xor(ssq, 32);
    __syncthreads();
    if (kh == 1) {
#pragma unroll
        for (int nb = 0; nb < 5; ++nb)
#pragma unroll
            for (int r = 0; r < 4; ++r) xb[(blk * 21 + nb * 4 + r) * 64 + lane] = acc[nb][r];
        xb[(blk * 21 + 20) * 64 + lane] = ssq;
    }
    __syncthreads();
    if (kh == 0) {
#pragma unroll
        for (int nb = 0; nb < 5; ++nb)
#pragma unroll
            for (int r = 0; r < 4; ++r) lg[(blk * 16 + 4 * l4 + r) * 81 + nb * 16 + l15] = acc[nb][r] + xb[(blk * 21 + nb * 4 + r) * 64 + lane];
        if (l4 == 0) lg[(blk * 16 + l15) * 81 + 80] = ssq + xb[(blk * 21 + 20) * 64 + lane];
    }
    __syncthreads();
    if (kh == 0 && lane < 16) {
        const int t = tile * 64 + blk * 16 + lane;
        const LAS float* L = lg + (blk * 16 + lane) * 81;
        const float r2 = 1.0f / sqrtf(L[80] * (1.0f / DM) + 1e-6f);
        float gl[8]; float gm = -3.0e38f; int gs = 0;
#pragma unroll
        for (int i = 0; i < 8; ++i) { gl[i] = L[i] * r2 + F.rg_b[i]; if (gl[i] > gm) { gm = gl[i]; gs = i; } }
        float gsum = 0.f;
#pragma unroll
        for (int i = 0; i < 8; ++i) gsum += __expf(gl[i] - gm);
        const float pg = 1.0f / gsum;
        float el[8]; float m0 = -3.0e38f, m1 = -3.0e38f; int i0 = 0, i1 = 0;
        #pragma unroll
        for (int i = 0; i < 8; ++i) { el[i] = L[8 + gs * 8 + i] * r2 + F.re_b[gs * 8 + i]; }
#pragma unroll
        for (int i = 0; i < 8; ++i) { if (el[i] > m0) { m1 = m0; i1 = i0; m0 = el[i]; i0 = i; } else if (el[i] > m1) { m1 = el[i]; i1 = i; } }
        const float e1 = __expf(m1 - m0);
        const float g0 = pg / (1.0f + e1), g1 = pg * e1 / (1.0f + e1);
        const int x0 = gs * 8 + i0, x1 = gs * 8 + i1;
        const int rk0 = (int)atomicAdd(F.ctl + cntw + x0, 1u), rk1 = (int)atomicAdd(F.ctl + cntw + x1, 1u);
        F.ROUTE_E[2 * t] = x0; F.ROUTE_E[2 * t + 1] = x1; F.ROUTE_R[2 * t] = rk0; F.ROUTE_R[2 * t + 1] = rk1;
        F.ROUTE_G[2 * t] = g0; F.ROUTE_G[2 * t + 1] = g1; F.R2[t] = r2;
    }
}
__device__ __forceinline__ void p6_gather(const Frame& F) {
    LAS int* tb = (LAS int*)F.lds;
    __syncthreads();
    if (F.tid == 0) { int acc = 0; for (int e = 0; e < NE; ++e) { tb[e] = acc; const int cnt = (int)__hip_atomic_load(F.ctl + CW_CNT + e, __ATOMIC_RELAXED, __HIP_MEMORY_SCOPE_AGENT); acc += (cnt + 255) >> 8; } tb[NE] = acc; }
    __syncthreads();
    if (blockIdx.x == 0) {
        if (F.tid < NE) { const int lo = tb[F.tid], hi = tb[F.tid + 1]; for (int i = lo; i < hi; ++i) F.TILEE[i] = F.tid; }
        if (F.tid == 0) F.ctl[CW_NT] = (unsigned)tb[NE];
    }
    const int gw = F.vcu * NWAVES + F.wave, NGW = F.G * NWAVES, lane = F.lane;
    f32x4 nw[8];
#pragma unroll
    for (int j = 0; j < 8; ++j) nw[j] = ((const f32x4*)F.norm2_w)[64 * j + lane];
    for (int t = gw; t < T; t += NGW) {
        const int e0 = F.ROUTE_E[2 * t], e1 = F.ROUTE_E[2 * t + 1];
        const int s0 = tb[e0] * 256 + F.ROUTE_R[2 * t], s1 = tb[e1] * 256 + F.ROUTE_R[2 * t + 1];
        const float r2 = F.R2[t];
        const f32x4* hr = (const f32x4*)(F.out + (size_t)t * DM) + lane;
        unsigned long long* o0 = (unsigned long long*)(F.XG + (size_t)s0 * DM) + lane;
        unsigned long long* o1 = (unsigned long long*)(F.XG + (size_t)s1 * DM) + lane;
#pragma unroll
        for (int j = 0; j < 8; ++j) { const f32x4 v = hr[64 * j] * r2 * nw[j];
            const unsigned long long w = (unsigned long long)pk2(v[0], v[1]) | ((unsigned long long)pk2(v[2], v[3]) << 32);
            o0[64 * j] = w; o1[64 * j] = w; }
        if (lane == 0) { F.SLOT[2 * t] = s0; F.SLOT[2 * t + 1] = s1; }
    }
}
__device__ __forceinline__ void p9_final(const Frame& F) {
    const int gw = F.vcu * NWAVES + F.wave, NGW = F.G * NWAVES, lane = F.lane;
    f32x4 fw[8];
#pragma unroll
    for (int j = 0; j < 8; ++j) fw[j] = ((const f32x4*)F.final_w)[64 * j + lane];
    for (int t = gw; t < T; t += NGW) {
        const int s0 = F.SLOT[2 * t], s1 = F.SLOT[2 * t + 1];
        const float g0 = F.ROUTE_G[2 * t], g1 = F.ROUTE_G[2 * t + 1];
        f32x4* hr = (f32x4*)(F.out + (size_t)t * DM) + lane;
        const v2u* y0 = (const v2u*)(F.Y + (size_t)s0 * DM) + lane;
        const v2u* y1 = (const v2u*)(F.Y + (size_t)s1 * DM) + lane;
        f32x4 v[8]; float ss = 0.f;
#pragma unroll
        for (int j = 0; j < 8; ++j) { const v2u a = y0[64 * j], c = y1[64 * j];
            const f32x4 ya = (f32x4){bflo(a.x), bfhi(a.x), bflo(a.y), bfhi(a.y)}, yc = (f32x4){bflo(c.x), bfhi(c.x), bflo(c.y), bfhi(c.y)};
            v[j] = hr[64 * j] + ya * g0 + yc * g1;
            ss += (v[j][0] * v[j][0] + v[j][1] * v[j][1]) + (v[j][2] * v[j][2] + v[j][3] * v[j][3]); }
        const float rs = 1.0f / sqrtf(wave_sum(ss) * (1.0f / DM) + 1e-6f);
#pragma unroll
        for (int j = 0; j < 8; ++j) hr[64 * j] = v[j] * rs * fw[j];
    }
}


struct Args { const float* in[29]; float* out; unsigned char* ws; int ph_lo, ph_hi; };
__global__ void __launch_bounds__(NTHR, 2) hybrid_fwd(Args args) {
    extern __shared__ __attribute__((aligned(16))) unsigned char lds[];
    Frame F;
    F.lds = (LAS unsigned char*)lds;
    F.MISC = (volatile LAS unsigned*)(F.lds + MISC_OFF);
    F.tid = threadIdx.x; F.lane = F.tid & 63; F.wave = __builtin_amdgcn_readfirstlane(F.tid >> 6);
    F.G = gridDim.x; { const int bx = blockIdx.x; F.vcu = (F.G % 8 == 0) ? (bx % 8) * (F.G / 8) + bx / 8 : bx; }
    unsigned char* ws = args.ws;
    F.ctl = (unsigned*)(ws + WS_CTL);
    F.x = args.in[0]; F.norm1_w = args.in[1]; F.w_in = args.in[2]; F.lam_q1 = args.in[3]; F.lam_k1 = args.in[4]; F.lam_q2 = args.in[5]; F.lam_k2 = args.in[6]; F.subln_w = args.in[7];
    F.rw_mu = args.in[8]; F.rw_w0 = args.in[9]; F.rw_w_up = args.in[10]; F.rw_a0 = args.in[11]; F.rw_a_up = args.in[12]; F.rw_g_up = args.in[13]; F.rw_k_k = args.in[14]; F.rw_k_a = args.in[15];
    F.rw_r_k = args.in[16]; F.rw_lnx_w = args.in[17]; F.rw_lnx_b = args.in[18]; F.w_out = args.in[19]; F.norm2_w = args.in[20]; F.rg_w = args.in[21]; F.rg_b = args.in[22]; F.re_w = args.in[23];
    F.re_b = args.in[24]; F.moe_w1 = args.in[25]; F.moe_w3 = args.in[26]; F.moe_w2 = args.in[27]; F.final_w = args.in[28];
    F.out = args.out;
    F.WIN = (bf16*)(ws + WS_WIN); F.WOUT = (bf16*)(ws + WS_WOUT); F.W13 = (bf16*)(ws + WS_W13); F.W2 = (bf16*)(ws + WS_W2);
    F.XN = (bf16*)(ws + WS_XN); F.MIX = (bf16*)(ws + WS_XN); F.Z = (bf16*)(ws + WS_Z); F.XG = (bf16*)(ws + WS_Z);
    F.STREAM = (bf16*)(ws + WS_STREAM); F.Y = (bf16*)(ws + WS_STREAM); F.HID = (bf16*)(ws + WS_HID);
    unsigned char* sm = ws + WS_SMALL;
    F.WUP = (bf16*)(sm + SM_WUP); F.AUP = (bf16*)(sm + SM_AUP); F.GUP = (bf16*)(sm + SM_GUP); F.WRT = (float*)(sm + SM_WRT); F.SC = (float*)(sm + SM_SC);
    F.ROUTE_E = (int*)(sm + SM_ROUTE_E); F.ROUTE_R = (int*)(sm + SM_ROUTE_R); F.ROUTE_G = (float*)(sm + SM_ROUTE_G); F.R2 = (float*)(sm + SM_R2); F.SLOT = (int*)(sm + SM_SLOT); F.TILEE = (int*)(sm + SM_TILEE);

    const int lo = args.ph_lo, hi = args.ph_hi;
    for (int u = F.tid; u < 64; u += NTHR) F.MISC[u] = 0u;
    __syncthreads();
    XcdBarrier bar; bar.bar = F.ctl + CW_BAR; bar.x = 0; bar.st = nullptr;
    if (hi - lo > 1) bar = xcd_barrier_post(F.ctl + CW_BAR, F.MISC + 8);
#define IN(k) (lo <= (k) && (k) < hi)
#define DUP(k) (DUP_PHASE == (k))
    unsigned long long st_t0 = 0, st_acc = 0; const bool st_me = (STALL_PHASE >= 0) && blockIdx.x == 0 && F.tid == 0;
#define TS(k) do { if (STALL_PHASE == (k) && st_me) st_t0 = __builtin_amdgcn_s_memrealtime(); } while (0)
#define TE(k) do { if (STALL_PHASE == (k) && st_me) st_acc += __builtin_amdgcn_s_memrealtime() - st_t0; } while (0)
#define SEAM(k) do { if (IN(k) && IN((k) + 1)) { if ((k) == 0) cg::this_grid().sync(); else xcd_barrier(bar); } } while (0)

    TS(0);
    if (IN(0)) { p0_prologue(F); if (DUP(0)) { __syncthreads(); p0_prologue(F); } SEAM(0); }
    TE(0);
    TS(1);
    if (IN(1)) {
        pg8::Gemm g{F.XN, F.WIN, T, INC, DM}; pg8::StaticOrder S; S.init(T, INC, F.G, (int)blockIdx.x);
        pg8::EpiBf16<0> E{F.Z, INC, nullptr, 0, 0, 1.0f};
        pg8::gemm_phase<pg8::EpiBf16<0>, pg8::StaticOrder, true, true>(F.lds, g, S, E);
        if (DUP(1)) { __syncthreads(); pg8::gemm_phase<pg8::EpiBf16<0>, pg8::StaticOrder, true, true>(F.lds, g, S, E); }
        SEAM(1);
    }
    TE(1);
    TS(2);
    if (IN(2)) { for (int u = F.vcu; u < T / 16; u += F.G) prep_unit(F, u, true); if (DUP(2)) { for (int u = F.vcu; u < T / 16; u += F.G) prep_unit(F, u, false); } SEAM(2); }
    TE(2);
    TS(3);
    if (IN(3)) { p3_mix(F, CW_QHEAD); if (DUP(3)) { p3_mix(F, CW_QHEAD + 1); } SEAM(3); }
    TE(3);
    TS(4);
    if (IN(4)) {
        pg8::Gemm g{F.MIX, F.WOUT, T, DM, DM}; pg8::StaticOrder S; S.init(T, DM, F.G, (int)blockIdx.x);
        pg8::EpiF32Res E{F.x, F.out, DM};
        pg8::gemm_phase<pg8::EpiF32Res, pg8::StaticOrder, true, true>(F.lds, g, S, E);
        if (DUP(4)) { __syncthreads(); pg8::gemm_phase<pg8::EpiF32Res, pg8::StaticOrder, true, true>(F.lds, g, S, E); }
        SEAM(4);
    }
    TE(4);
    TS(5);
    if (IN(5)) { for (int tl = F.vcu; tl < T / 64; tl += F.G) router_tile(F, tl, CW_CNT); if (DUP(5)) { for (int tl = F.vcu; tl < T / 64; tl += F.G) router_tile(F, tl, CW_CNT + 64); } SEAM(5); }
    TE(5);
    TS(6);
    if (IN(6)) { p6_gather(F); if (DUP(6)) { p6_gather(F); } SEAM(6); }
    TE(6);
    TS(7);
    if (IN(7)) {
        const int nT = __builtin_amdgcn_readfirstlane((int)__hip_atomic_load(F.ctl + CW_NT, __ATOMIC_RELAXED, __HIP_MEMORY_SCOPE_AGENT));
        pg8::Gemm g{F.XG, F.W13, PMAX, NE * 1024, DM}; pg8::MoeOrder S{F.TILEE, nT * 4, 4, F.G, (int)blockIdx.x};
        pg8::EpiSwiGLU E{F.HID};
        pg8::gemm_phase<pg8::EpiSwiGLU, pg8::MoeOrder, true, true>(F.lds, g, S, E);
        if (DUP(7)) { __syncthreads(); pg8::gemm_phase<pg8::EpiSwiGLU, pg8::MoeOrder, true, true>(F.lds, g, S, E); }
        SEAM(7);
    }
    TE(7);
    TS(8);
    if (IN(8)) {
        const int nT = __builtin_amdgcn_readfirstlane((int)__hip_atomic_load(F.ctl + CW_NT, __ATOMIC_RELAXED, __HIP_MEMORY_SCOPE_AGENT));
        pg8::Gemm g{F.HID, F.W2, PMAX, NE * 2048, DE}; pg8::MoeOrder S{F.TILEE, nT * 8, 8, F.G, (int)blockIdx.x};
        pg8::EpiBf16<0> E{F.Y, DM, nullptr, 2048, 0, 1.0f};
        pg8::gemm_phase<pg8::EpiBf16<0>, pg8::MoeOrder, true, true>(F.lds, g, S, E);
        if (DUP(8)) { __syncthreads(); pg8::gemm_phase<pg8::EpiBf16<0>, pg8::MoeOrder, true, true>(F.lds, g, S, E); }
        SEAM(8);
    }
    if (DUP(10)) { for (int i = 0; i < 10; ++i) xcd_barrier(bar); }
    TE(8);
    TS(9);
    if (IN(9)) { p9_final(F); }
    TE(9);
    if (st_me) { const unsigned long long t1 = __builtin_amdgcn_s_memrealtime(); while (__builtin_amdgcn_s_memrealtime() - t1 < st_acc) __builtin_amdgcn_s_sleep(8); }
#undef IN
#undef SEAM
}

extern "C" void kernel_launch(void* const* d_in, const int* in_sizes, int n_in, void* d_out, int out_size, void* d_ws, size_t ws_size, hipStream_t stream) {
    static int grid = 0;
    if (grid == 0) {
        if (n_in != 29 || in_sizes[0] != T * DM || out_size != T * DM || ws_size < WS_END) {
            fprintf(stderr, "kernel_launch: unexpected shapes (n_in %d, in0 %d, out %d, ws %zu; need ws >= %zu); nothing launched\n", n_in, n_in > 0 ? in_sizes[0] : -1, out_size, ws_size, (size_t)WS_END);
            grid = -1; return; }
        int dev = 0, cus = 0, per_cu = 0;
        if (hipGetDevice(&dev) != hipSuccess || hipDeviceGetAttribute(&cus, hipDeviceAttributeMultiprocessorCount, dev) != hipSuccess) { fprintf(stderr, "kernel_launch: device query failed\n"); grid = -1; return; }
        if (hipFuncSetAttribute((const void*)hybrid_fwd, hipFuncAttributeMaxDynamicSharedMemorySize, LDS_BYTES) != hipSuccess) { fprintf(stderr, "kernel_launch: hipFuncSetAttribute failed\n"); grid = -1; return; }
        if (hipOccupancyMaxActiveBlocksPerMultiprocessor(&per_cu, (const void*)hybrid_fwd, NTHR, LDS_BYTES) != hipSuccess || per_cu < 1) {
            fprintf(stderr, "kernel_launch: occupancy query reports %d blocks per CU\n", per_cu); (void)hipGetLastError(); per_cu = 1; }
        grid = cus;
        fprintf(stderr, "kernel_launch: grid %d (per_cu query %d), launches %d\n", grid, per_cu, N_LAUNCHES);
    }
    if (grid < 0) return;
    (void)hipMemsetAsync((char*)d_ws + WS_CTL, 0, CTL_ZERO_BYTES, stream);
    Args a{};
    for (int i = 0; i < 29; ++i) a.in[i] = (const float*)d_in[i];
    a.out = (float*)d_out; a.ws = (unsigned char*)d_ws;
    if (N_LAUNCHES == 1) {
        a.ph_lo = 0; a.ph_hi = NPHASE;
        void* kargs[] = {&a};
        hipError_t e = hipLaunchCooperativeKernel((const void*)hybrid_fwd, dim3(grid), dim3(NTHR), kargs, LDS_BYTES, stream);
        if (e != hipSuccess) fprintf(stderr, "kernel_launch: cooperative launch failed: %s (grid %d)\n", hipGetErrorString(e), grid);
    } else {
        for (int ph = 0; ph < NPHASE; ++ph) {
            a.ph_lo = ph; a.ph_hi = ph + 1;
            hipLaunchKernelGGL(hybrid_fwd, dim3(grid), dim3(NTHR), LDS_BYTES, stream, a);
            const hipError_t le = hipPeekAtLastError();
            if (le != hipSuccess) { fprintf(stderr, "kernel_launch: launch %d failed: %s\n", ph, hipGetErrorName(le)); break; }
        }
    }
}
```
